# Optimizing an MI355X kernel written in HIP

```python
import jax
import jax.numpy as jnp
from jax import lax
import numpy as np

D_MODEL = 2048
BATCH = 4
SEQ = 8192
DEPTH = 1
DEC_BATCH = 8
DEC_SEQ = 2048
PAST_LEN = 128

HEAD_DIM = 128
N_HEADS_A = D_MODEL // 256
N_KV_A = max(1, N_HEADS_A // 4)
GROUP_A = N_HEADS_A // N_KV_A
N_HEADS_B = D_MODEL // 256
N_KV_B = max(1, N_HEADS_B // 4)
GROUP_B = N_HEADS_B // N_KV_B
Q_WIDTH_A = N_HEADS_A * HEAD_DIM
KV_WIDTH_A = N_KV_A * HEAD_DIM
Q_WIDTH_B = N_HEADS_B * HEAD_DIM
KV_WIDTH_B = N_KV_B * HEAD_DIM
IN_COLS = Q_WIDTH_A + 2 * KV_WIDTH_A + Q_WIDTH_B + 2 * KV_WIDTH_B + 2 * D_MODEL
D_FF = ((8 * D_MODEL // 3 + 255) // 256) * 256
CONV_WIDTH = 3
BLOCK_Q = 128
WINDOW = 128
GRID_W = 64
ROPE_THETA = 10000.0
EPS = 1e-6

kernel_name = 'hybrid_gated_axial_window_encoder'


def rms_norm(x, gain):
    xf = x.astype(jnp.float32)
    xf = xf * lax.rsqrt(jnp.mean(xf * xf, axis=-1, keepdims=True) + EPS)
    return (xf * gain.astype(jnp.float32)).astype(x.dtype)


def rope_cos_sin(pos, dim):
    inv_freq = ROPE_THETA ** (-jnp.arange(0, dim, 2, dtype=jnp.float32) / dim)
    ang = pos.astype(jnp.float32)[:, None] * inv_freq[None, :]
    ang = jnp.concatenate([ang, ang], axis=-1)
    return jnp.cos(ang), jnp.sin(ang)


def apply_rope(x, cos, sin):
    half = x.shape[-1] // 2
    xf = x.astype(jnp.float32)
    rot = jnp.concatenate([-xf[..., half:], xf[..., :half]], axis=-1)
    return (xf * cos[None, :, None, :] + rot * sin[None, :, None, :]).astype(x.dtype)


def apply_axial_rope(x, cos_r, sin_r, cos_c, sin_c):
    h = HEAD_DIM // 2
    return jnp.concatenate([apply_rope(x[..., :h], cos_r, sin_r),
                            apply_rope(x[..., h:], cos_c, sin_c)], axis=-1)


def dense_attention(q, k, v):
    B, S, Hkv, G, Dh = q.shape
    nb = S // BLOCK_Q
    qb = q.reshape(B, nb, BLOCK_Q, Hkv, G, Dh).transpose(1, 0, 2, 3, 4, 5)
    scale = Dh ** -0.5

    def one_block(qi):
        s = jnp.einsum('bqhgd,bkhd->bhgqk', qi, k, preferred_element_type=jnp.float32) * scale
        p = jax.nn.softmax(s, axis=-1)
        return jnp.einsum('bhgqk,bkhd->bqhgd', p.astype(v.dtype), v)

    o = lax.map(one_block, qb)
    return o.transpose(1, 0, 2, 3, 4, 5).reshape(B, S, Hkv * G * Dh)


def windowed_attention(q, k, v, sink):
    B, S, Hkv, G, Dh = q.shape
    nb = S // BLOCK_Q
    span = BLOCK_Q + 2 * WINDOW
    kp = jnp.pad(k, ((0, 0), (WINDOW, WINDOW), (0, 0), (0, 0)))
    vp = jnp.pad(v, ((0, 0), (WINDOW, WINDOW), (0, 0), (0, 0)))
    a = jnp.arange(BLOCK_Q)[:, None]
    b = jnp.arange(span)[None, :]
    band = (b >= a) & (b <= a + 2 * WINDOW)
    qb = q.reshape(B, nb, BLOCK_Q, Hkv, G, Dh).transpose(1, 0, 2, 3, 4, 5)
    sink_l = sink.astype(jnp.float32).reshape(Hkv, G)[None, :, :, None, None]
    scale = Dh ** -0.5

    def one_block(args):
        i, qi = args
        start = i * BLOCK_Q
        ki = lax.dynamic_slice_in_dim(kp, start, span, axis=1)
        vi = lax.dynamic_slice_in_dim(vp, start, span, axis=1)
        key_pos = start - WINDOW + jnp.arange(span)
        valid = band & ((key_pos >= 0) & (key_pos < S))[None, :]
        s = jnp.einsum('bqhgd,bkhd->bhgqk', qi, ki, preferred_element_type=jnp.float32) * scale
        s = jnp.where(valid, s, -jnp.inf)
        m = jnp.maximum(jnp.max(s, axis=-1, keepdims=True), sink_l)
        p = jnp.exp(s - m)
        p = p / (jnp.sum(p, axis=-1, keepdims=True) + jnp.exp(sink_l - m))
        return jnp.einsum('bhgqk,bkhd->bqhgd', p.astype(vi.dtype), vi)

    o = lax.map(one_block, (jnp.arange(nb), qb))
    return o.transpose(1, 0, 2, 3, 4, 5).reshape(B, S, Hkv * G * Dh)


def token_mixer(h, w_in, q_norm_a, k_norm_a, sink_b, w_branch_a, w_branch_b, w_out):
    B, S, _ = h.shape
    rows = S // GRID_W
    t = jnp.arange(S, dtype=jnp.int32)
    row_pos = jnp.repeat(jnp.arange(rows, dtype=jnp.int32), GRID_W)
    col_pos = jnp.tile(jnp.arange(GRID_W, dtype=jnp.int32), rows)
    cos_r, sin_r = rope_cos_sin(row_pos, HEAD_DIM // 2)
    cos_c, sin_c = rope_cos_sin(col_pos, HEAD_DIM // 2)
    cos_t, sin_t = rope_cos_sin(t, HEAD_DIM)

    proj = h @ w_in
    sizes = (Q_WIDTH_A, KV_WIDTH_A, KV_WIDTH_A, Q_WIDTH_B, KV_WIDTH_B, KV_WIDTH_B, D_MODEL, D_MODEL)
    offsets = [sum(sizes[:i]) for i in range(1, len(sizes))]
    qa, ka, va, qb, kb, vb, gate_a, gate_b = jnp.split(proj, offsets, axis=-1)

    qa = rms_norm(qa.reshape(B, S, N_HEADS_A, HEAD_DIM), q_norm_a)
    ka = rms_norm(ka.reshape(B, S, N_KV_A, HEAD_DIM), k_norm_a)
    qa = apply_axial_rope(qa, cos_r, sin_r, cos_c, sin_c)
    ka = apply_axial_rope(ka, cos_r, sin_r, cos_c, sin_c)
    va = va.reshape(B, S, N_KV_A, HEAD_DIM)
    o_a = dense_attention(qa.reshape(B, S, N_KV_A, GROUP_A, HEAD_DIM), ka, va)

    qb = apply_rope(qb.reshape(B, S, N_HEADS_B, HEAD_DIM), cos_t, sin_t)
    kb = apply_rope(kb.reshape(B, S, N_KV_B, HEAD_DIM), cos_t, sin_t)
    vb = vb.reshape(B, S, N_KV_B, HEAD_DIM)
    o_b = windowed_attention(qb.reshape(B, S, N_KV_B, GROUP_B, HEAD_DIM), kb, vb, sink_b)

    merged = jax.nn.sigmoid(gate_a) * (o_a @ w_branch_a) + jax.nn.sigmoid(gate_b) * (o_b @ w_branch_b)
    return merged @ w_out


def channel_mixer(h, w_up, conv_w, conv_b, w_down):
    S = h.shape[1]
    up = h @ w_up
    pad = CONV_WIDTH // 2
    up_p = jnp.pad(up, ((0, 0), (pad, pad), (0, 0)))
    conv = conv_b
    for j in range(CONV_WIDTH):
        conv = conv + up_p[:, j:j + S] * conv_w[j]
    a, b = jnp.split(conv, 2, axis=-1)
    return (jax.nn.gelu(a, approximate=True) * b) @ w_down


def run_trunk(x, norm_pre_mix, w_in, q_norm_a, k_norm_a, sink_b, w_branch_a, w_branch_b, w_out,
              norm_post_mix, norm_pre_ffn, w_up, conv_w, conv_b, w_down, norm_post_ffn):
    for l in range(DEPTH):
        h = rms_norm(x, norm_pre_mix[l])
        mix = token_mixer(h, w_in[l], q_norm_a[l], k_norm_a[l], sink_b[l],
                          w_branch_a[l], w_branch_b[l], w_out[l])
        x = x + rms_norm(mix, norm_post_mix[l])
        h = rms_norm(x, norm_pre_ffn[l])
        ffn = channel_mixer(h, w_up[l], conv_w[l], conv_b[l], w_down[l])
        x = x + rms_norm(ffn, norm_post_ffn[l])
    return x


def setup_inputs(seed: int = 0) -> dict:
    key = jax.random.key(seed)
    ks = jax.random.split(key, 17)
    f32 = jnp.float32

    def dense(k, shape, fan_in):
        return jax.random.normal(k, shape, f32) * fan_in ** -0.5

    def gain(k, n):
        return 1.0 + 0.05 * jax.random.normal(k, (DEPTH, n), f32)

    return {
        'x_prompt': jax.random.normal(ks[0], (BATCH, SEQ, D_MODEL), f32),
        'x_sample': jax.random.normal(ks[1], (DEC_BATCH, DEC_SEQ, D_MODEL), f32),
        'norm_pre_mix': gain(ks[2], D_MODEL),
        'w_in': dense(ks[3], (DEPTH, D_MODEL, IN_COLS), D_MODEL),
        'q_norm_a': gain(ks[4], HEAD_DIM),
        'k_norm_a': gain(ks[5], HEAD_DIM),
        'sink_b': 0.5 * jax.random.normal(ks[6], (DEPTH, N_HEADS_B), f32),
        'w_branch_a': dense(ks[7], (DEPTH, Q_WIDTH_A, D_MODEL), Q_WIDTH_A),
        'w_branch_b': dense(ks[8], (DEPTH, Q_WIDTH_B, D_MODEL), Q_WIDTH_B),
        'w_out': dense(ks[9], (DEPTH, D_MODEL, D_MODEL), D_MODEL),
        'norm_post_mix': gain(ks[10], D_MODEL),
        'norm_pre_ffn': gain(ks[11], D_MODEL),
        'w_up': dense(ks[12], (DEPTH, D_MODEL, 2 * D_FF), D_MODEL),
        'conv_w': dense(ks[13], (DEPTH, CONV_WIDTH, 2 * D_FF), CONV_WIDTH),
        'conv_b': 0.02 * jax.random.normal(ks[14], (DEPTH, 2 * D_FF), f32),
        'w_down': dense(ks[15], (DEPTH, D_FF, D_MODEL), D_FF),
        'norm_post_ffn': gain(ks[16], D_MODEL),
    }


def reference(x_prompt, x_sample, norm_pre_mix, w_in, q_norm_a, k_norm_a, sink_b, w_branch_a,
              w_branch_b, w_out, norm_post_mix, norm_pre_ffn, w_up, conv_w, conv_b, w_down,
              norm_post_ffn):
    y_prompt = run_trunk(x_prompt, norm_pre_mix, w_in, q_norm_a, k_norm_a, sink_b, w_branch_a,
                         w_branch_b, w_out, norm_post_mix, norm_pre_ffn, w_up, conv_w, conv_b,
                         w_down, norm_post_ffn)
    y_sample = run_trunk(x_sample, norm_pre_mix, w_in, q_norm_a, k_norm_a, sink_b, w_branch_a,
                         w_branch_b, w_out, norm_post_mix, norm_pre_ffn, w_up, conv_w, conv_b,
                         w_down, norm_post_ffn)
    return (y_prompt, y_sample)
```

```cpp
#define SD_DENSE 1
#define SD_WIN 1
#define P4_ALIGN true
#define WGM_P4 6
#include <hip/hip_runtime.h>
#include <hip/hip_cooperative_groups.h>
#include <hip/hip_bf16.h>
#include <cstdio>
#include <cstdint>
#include <cmath>
namespace cg = cooperative_groups;

constexpr int NTOK = 49152, NPROMPT = 32768, DM = 2048, NIN = 7168, DFF = 5632, NUP = 11264;
constexpr int MT_UP = 194, NPAD = 254 * (MT_UP - 1) + 256 + 2;
constexpr size_t WS_TOKMAP = 131072;
constexpr float RMS_EPS = 1e-6f;
constexpr size_t MiB = 1u << 20;
constexpr size_t WS_COST = 1 * MiB, WS_SINT = 3 * MiB, WS_AX = 5 * MiB;
constexpr size_t WS_WIN = 6 * MiB, WS_WA = 34 * MiB, WS_WB = 38 * MiB, WS_WOUT = 42 * MiB, WS_WUP = 50 * MiB, WS_WDOWN = 94 * MiB;
constexpr size_t WS_SSQ = 116 * MiB;
constexpr size_t WS_H = 124 * MiB;
constexpr size_t WS_OA = 124 * MiB, WS_OB = 220 * MiB;
constexpr size_t WS_QA = 320 * MiB, WS_KA = 416 * MiB, WS_VA = 440 * MiB, WS_QB = 464 * MiB, WS_KB = 560 * MiB, WS_VB = 584 * MiB, WS_GA = 608 * MiB, WS_GB = 800 * MiB;
constexpr size_t WS_MIX = 512 * MiB;
constexpr size_t WS_X1A = 848 * MiB, WS_X1B = 6 * MiB; constexpr int X1_SPLIT = 45056;
constexpr size_t WS_MERGED = 320 * MiB, WS_ACT = 320 * MiB, WS_END = 1024 * MiB;
static_assert(WS_H + (size_t)NPAD * DM * 2 <= WS_QA && WS_ACT + (size_t)NTOK * DFF * 2 <= WS_END && WS_GB + (size_t)NTOK * DM * 2 <= WS_END, "ws map");
constexpr int LDS_BYTES = 147456;

namespace pg8 {
#define PG8_LAS __attribute__((address_space(3)))
typedef unsigned short bf16_t;
typedef short bf16x8 __attribute__((ext_vector_type(8)));
typedef float f32x4 __attribute__((ext_vector_type(4)));
typedef unsigned u32x4 __attribute__((ext_vector_type(4)));
constexpr int BM = 256, BK = 64, HALF = 128, HTB = HALF * BK * 2  , STAGE_BYTES = 8 * HTB, NXCD = 8, WGM = 8;

__host__ __device__ __forceinline__ int lds_byte(int r, int c) { const int st = (r >> 4) * 2 + (c >> 5), rr = r & 15, cc = c & 31, ob = rr * 64 + cc * 2; return st * 1024 + (ob ^ (((ob >> 9) & 1) << 5)); }
__host__ __device__ __forceinline__ void stage_rc(int b, int& R, int& C) { const int st = b / 1024, sb = b % 1024, swz = sb ^ (((sb >> 9) & 1) << 5); R = (st >> 1) * 16 + swz / 64; C = (st & 1) * 32 + (swz % 64) / 2; }
__host__ __device__ __forceinline__ int perm32(int rho) { const int n = rho >> 4, i = rho & 15; return 8 * (i >> 2) + 4 * n + (i & 3); }

struct Unit { int pm, pn, sel; };
struct Gemm { const bf16_t* A; const bf16_t* Bt; int M, N, K; const bf16_t* A2; const bf16_t* Bt2; };

struct StaticOrder {
    int nM, nN, nwg, G, c, wgm;
    __host__ __device__ void init(int M, int N, int G_, int c_, int wgm_ = WGM) { nM = M / BM; nN = N / BM; nwg = nM * nN; G = G_; c = c_; wgm = wgm_; }
    __host__ __device__ bool next(int i, Unit& u) const {
        const long L = (long)i * G + c; if (L >= nwg) return false;
        int wgid = (int)L; { const int q = nwg / NXCD, r = nwg % NXCD, xcd = wgid % NXCD, off = wgid / NXCD; wgid = (xcd < r ? xcd * (q + 1) : r * (q + 1) + (xcd - r) * q) + off; }
        const int nig = wgm * nN, gid = wgid / nig, fm = gid * wgm, gsz = (nM - fm) < wgm ? (nM - fm) : wgm;
        u.pm = fm + ((wgid % nig) % gsz); u.pn = (wgid % nig) / gsz; u.sel = 0; return true;
    }
    __device__ __forceinline__ void a_ready(const Unit&) const {}
    __device__ __forceinline__ void done(const Unit&) const {}
};
struct PairOrder {
    StaticOrder base;
    __host__ __device__ bool next(int i, Unit& u) const { const bool ok = base.next(i >> 1, u); u.sel = i & 1; return ok; }
    __device__ __forceinline__ void a_ready(const Unit&) const {}
    __device__ __forceinline__ void done(const Unit&) const {}
};

__device__ __forceinline__ unsigned cvt_pk_bf16(float lo, float hi) { unsigned r; asm volatile("v_cvt_pk_bf16_f32 %0, %1, %2" : "=v"(r) : "v"(lo), "v"(hi)); return r; }
typedef float f32x2 __attribute__((ext_vector_type(2)));
typedef unsigned u32x2 __attribute__((ext_vector_type(2)));
__device__ __forceinline__ float bf_lo(unsigned w) { return __uint_as_float(w << 16); }
__device__ __forceinline__ float bf_hi(unsigned w) { return __uint_as_float(w & 0xffff0000u); }
__device__ __forceinline__ float sigmoidf_(float v) { return __builtin_amdgcn_rcpf(1.0f + __builtin_amdgcn_exp2f(-1.4426950408889634f * v)); }
__device__ __forceinline__ u32x4 pack8(const f32x4 v0, const f32x4 v1) { u32x4 w; w.x = cvt_pk_bf16(v0[0], v0[1]); w.y = cvt_pk_bf16(v0[2], v0[3]); w.z = cvt_pk_bf16(v1[0], v1[1]); w.w = cvt_pk_bf16(v1[2], v1[3]); return w; }

struct EpiProj {
    static constexpr bool PERM = true, AFTER_DRAIN = false;
    unsigned char* ws; const float* qg; const float* kg; PG8_LAS float* xl;
    __device__ __forceinline__ void operator()(const f32x4 (&acc)[2][2][4][2], const Unit& u, int wr, int wc, int fr, int fq) const {
        const int pn = u.pn;
        int mode, ld, colt, hbase = 0; size_t boff; const float* gain = qg;
        if (pn < 4)        { mode = 1; boff = WS_QA; ld = 1024; colt = pn * 256; hbase = 2 * pn; }
        else if (pn == 4)  { mode = 1; boff = WS_KA; ld = 256;  colt = 0; hbase = 8; gain = kg; }
        else if (pn == 5)  { mode = 0; boff = WS_VA; ld = 256;  colt = 0; }
        else if (pn < 10)  { mode = 2; boff = WS_QB; ld = 1024; colt = (pn - 6) * 256; }
        else if (pn == 10) { mode = 2; boff = WS_KB; ld = 256;  colt = 0; }
        else if (pn == 11) { mode = 0; boff = WS_VB; ld = 256;  colt = 0; }
        else if (pn < 20)  { mode = 3; boff = WS_GA; ld = 2048; colt = (pn - 12) * 256; }
        else               { mode = 3; boff = WS_GB; ld = 2048; colt = (pn - 20) * 256; }
        bf16_t* base = (bf16_t*)(ws + boff);
        const int col0 = colt + wc * 32 + 8 * fq;
        const int row0 = u.pm * BM + wr * 64 + fr;
        if (mode == 0 || mode == 3) {
#pragma unroll
            for (int ai = 0; ai < 2; ++ai)
#pragma unroll
                for (int m = 0; m < 4; ++m) { bf16_t* rowp = base + (size_t)(row0 + ai * HALF + m * 16) * ld + col0;
#pragma unroll
                    for (int bj = 0; bj < 2; ++bj) { f32x4 v0 = acc[ai][bj][m][0], v1 = acc[ai][bj][m][1];
                        if (mode == 3) {
#pragma unroll
                            for (int j = 0; j < 4; ++j) { v0[j] = sigmoidf_(v0[j]); v1[j] = sigmoidf_(v1[j]); } }
                        *(u32x4*)(rowp + bj * HALF) = pack8(v0, v1); } }
        } else if (mode == 2) {
            const float* ct = (const float*)(ws + WS_COST) + wc * 16 + fq * 4; const float* st = (const float*)(ws + WS_SINT) + wc * 16 + fq * 4;
#pragma unroll
            for (int ai = 0; ai < 2; ++ai)
#pragma unroll
                for (int m = 0; m < 4; ++m) { const int tok = row0 + ai * HALF + m * 16; const int t = tok < NPROMPT ? (tok & 8191) : (tok & 2047);
                    const f32x4 c = *(const f32x4*)(ct + t * 64), s = *(const f32x4*)(st + t * 64);
                    bf16_t* rowp = base + (size_t)tok * ld + col0;
#pragma unroll
                    for (int bj = 0; bj < 2; ++bj) { const f32x4 lo = acc[ai][bj][m][0], hi = acc[ai][bj][m][1];
                        *(u32x4*)(rowp + bj * HALF) = pack8(lo * c - hi * s, hi * c + lo * s); } }
        } else {
            const int dlo = 64 * (wc >> 1) + 16 * (wc & 1) + 4 * fq;
            const f32x4 glo = *(const f32x4*)(gain + dlo), ghi = *(const f32x4*)(gain + dlo + 32);
            const float* axt = (const float*)(ws + WS_AX) + ((wc >> 1) ? 8192 : 0);
            const int sinoff = (wc >> 1) ? 2048 : 4096, fi = 16 * (wc & 1) + 4 * fq;
            PG8_LAS float* xq = xl + ((wr * 64 + fr) * 2) * 4 + wc;
#pragma unroll
            for (int ai = 0; ai < 2; ++ai)
#pragma unroll
                for (int m = 0; m < 4; ++m)
#pragma unroll
                    for (int bj = 0; bj < 2; ++bj) { const f32x4 r0 = acc[ai][bj][m][0], r1 = acc[ai][bj][m][1];
                        float q = (r0[0] * r0[0] + r0[1] * r0[1]) + (r0[2] * r0[2] + r0[3] * r0[3]) + (r1[0] * r1[0] + r1[1] * r1[1]) + (r1[2] * r1[2] + r1[3] * r1[3]);
                        q += __shfl_xor(q, 16); q += __shfl_xor(q, 32);
                        if (fq == 0) xq[((ai * HALF + m * 16) * 2 + bj) * 4] = q; }
            asm volatile("s_waitcnt lgkmcnt(0)" ::: "memory"); __builtin_amdgcn_s_barrier(); asm volatile("" ::: "memory");
#pragma unroll
            for (int ai = 0; ai < 2; ++ai)
#pragma unroll
                for (int m = 0; m < 4; ++m) { const int tok = row0 + ai * HALF + m * 16; const int t = tok < NPROMPT ? (tok & 8191) : (tok & 2047);
                    const int pos = (wc >> 1) ? (t & 63) : (t >> 6);
                    const f32x4 c = *(const f32x4*)(axt + pos * 32 + fi), s = *(const f32x4*)(axt + sinoff + pos * 32 + fi);
                    bf16_t* rowp = base + (size_t)tok * ld + col0;
#pragma unroll
                    for (int bj = 0; bj < 2; ++bj) {
                        const f32x4 pp = *(const PG8_LAS f32x4*)(xl + ((wr * 64 + fr + ai * HALF + m * 16) * 2 + bj) * 4);
                        const float rstd = 1.0f / sqrtf(((pp[0] + pp[1]) + (pp[2] + pp[3])) * (1.0f / 128.0f) + RMS_EPS);
                        const f32x4 lo = acc[ai][bj][m][0] * glo * rstd, hi = acc[ai][bj][m][1] * ghi * rstd;
                        *(u32x4*)(rowp + bj * HALF) = pack8(lo * c - hi * s, hi * c + lo * s); } }
        }
    }
};

struct EpiGate2 {
    static constexpr bool PERM = true, AFTER_DRAIN = false;
    const bf16_t* ga; const bf16_t* gb; bf16_t* merged;
    __device__ __forceinline__ void mid(f32x4 (&acc)[2][2][4][2], const Unit& u, int wr, int wc, int fr, int fq) const {
        const int row0 = u.pm * BM + wr * 64 + fr, col0 = u.pn * BM + wc * 32 + 8 * fq;
#pragma unroll
        for (int ai = 0; ai < 2; ++ai)
#pragma unroll
            for (int m = 0; m < 4; ++m) { const size_t off = (size_t)(row0 + ai * HALF + m * 16) * DM + col0;
#pragma unroll
                for (int bj = 0; bj < 2; ++bj) { const u32x4 a = __builtin_nontemporal_load((const u32x4*)(ga + off + bj * HALF)), b = *(const u32x4*)(gb + off + bj * HALF);
                    const f32x4 a0 = {bf_lo(a.x), bf_hi(a.x), bf_lo(a.y), bf_hi(a.y)}, a1 = {bf_lo(a.z), bf_hi(a.z), bf_lo(a.w), bf_hi(a.w)};
                    f32x4 b0 = {bf_lo(b.x), bf_hi(b.x), bf_lo(b.y), bf_hi(b.y)}, b1 = {bf_lo(b.z), bf_hi(b.z), bf_lo(b.w), bf_hi(b.w)};
#pragma unroll
                    for (int j = 0; j < 4; ++j) { b0[j] = __builtin_amdgcn_rcpf(fmaxf(b0[j], 1e-30f)); b1[j] = __builtin_amdgcn_rcpf(fmaxf(b1[j], 1e-30f)); }
                    acc[ai][bj][m][0] = acc[ai][bj][m][0] * (a0 * b0); acc[ai][bj][m][1] = acc[ai][bj][m][1] * (a1 * b1); } }
    }
    __device__ __forceinline__ void operator()(const f32x4 (&acc)[2][2][4][2], const Unit& u, int wr, int wc, int fr, int fq) const {
        const int row0 = u.pm * BM + wr * 64 + fr, col0 = u.pn * BM + wc * 32 + 8 * fq;
#pragma unroll
        for (int ai = 0; ai < 2; ++ai)
#pragma unroll
            for (int m = 0; m < 4; ++m) { const size_t off = (size_t)(row0 + ai * HALF + m * 16) * DM + col0;
#pragma unroll
                for (int bj = 0; bj < 2; ++bj) { const u32x4 b = *(const u32x4*)(gb + off + bj * HALF);
                    f32x4 b0 = {bf_lo(b.x), bf_hi(b.x), bf_lo(b.y), bf_hi(b.y)}, b1 = {bf_lo(b.z), bf_hi(b.z), bf_lo(b.w), bf_hi(b.w)};
#pragma unroll
                    for (int j = 0; j < 4; ++j) { b0[j] = fmaxf(b0[j], 1e-30f); b1[j] = fmaxf(b1[j], 1e-30f); }
                    *(u32x4*)(merged + off + bj * HALF) = pack8(acc[ai][bj][m][0] * b0, acc[ai][bj][m][1] * b1); } }
    }
};
struct EpiF32 {
    static constexpr bool PERM = true, AFTER_DRAIN = false;
    float* O;
    __device__ __forceinline__ void operator()(const f32x4 (&acc)[2][2][4][2], const Unit& u, int wr, int wc, int fr, int fq) const {
        const int row0 = u.pm * BM + wr * 64 + fr, col0 = u.pn * BM + wc * 32 + 8 * fq;
#pragma unroll
        for (int ai = 0; ai < 2; ++ai)
#pragma unroll
            for (int m = 0; m < 4; ++m) { float* rowp = O + (size_t)(row0 + ai * HALF + m * 16) * DM + col0;
#pragma unroll
                for (int bj = 0; bj < 2; ++bj) { *(f32x4*)(rowp + bj * HALF) = acc[ai][bj][m][0]; *(f32x4*)(rowp + bj * HALF + 4) = acc[ai][bj][m][1]; } }
    }
};
struct EpiBf16Plain {
    static constexpr bool PERM = true, AFTER_DRAIN = false;
    bf16_t* O;
    __device__ __forceinline__ void operator()(const f32x4 (&acc)[2][2][4][2], const Unit& u, int wr, int wc, int fr, int fq) const {
        const int row0 = u.pm * BM + wr * 64 + fr, col0 = u.pn * BM + wc * 32 + 8 * fq;
#pragma unroll
        for (int ai = 0; ai < 2; ++ai)
#pragma unroll
            for (int m = 0; m < 4; ++m) { bf16_t* rowp = O + (size_t)(row0 + ai * HALF + m * 16) * DM + col0;
#pragma unroll
                for (int bj = 0; bj < 2; ++bj) *(u32x4*)(rowp + bj * HALF) = pack8(acc[ai][bj][m][0], acc[ai][bj][m][1]); }
    }
};
__device__ __forceinline__ float dpp_shr1(float v) { return __builtin_bit_cast(float, __builtin_amdgcn_update_dpp(0, __builtin_bit_cast(int, v), 0x111, 0xf, 0xf, true)); }
__device__ __forceinline__ float dpp_shl1(float v) { return __builtin_bit_cast(float, __builtin_amdgcn_update_dpp(0, __builtin_bit_cast(int, v), 0x101, 0xf, 0xf, true)); }
__device__ __forceinline__ float dpp_mirror(float v) { return __builtin_bit_cast(float, __builtin_amdgcn_update_dpp(0, __builtin_bit_cast(int, v), 0x140, 0xf, 0xf, true)); }
__device__ __forceinline__ float gelu_tanh_(float a) { const float u2 = a * (1.5957691216f + 0.0713548163f * a * a); return a * __builtin_amdgcn_rcpf(1.0f + __builtin_amdgcn_exp2f(-1.4426950408889634f * u2)); }
__host__ __device__ __forceinline__ int conv_row_token(int P) {
    if (P < 32772) { const int s = P / 8193, r = P - 8193 * s; return r >= 1 ? 8192 * s + r - 1 : -1; }
    if (P < 49165) { const int Q = P - 32772, s2 = Q / 2049, r = Q - 2049 * s2; return r >= 1 ? NPROMPT + 2048 * s2 + r - 1 : -1; }
    return -1;
}
struct EpiConv {
    static constexpr bool PERM = true, AFTER_DRAIN = false;
    const float* cw; const float* cb; bf16_t* act; const int* tokmap;
    __device__ __forceinline__ void operator()(const f32x4 (&acc)[2][2][4][2], const Unit& u, int wr, int wc, int fr, int fq) const {
        PG8_LAS float* const xb = (PG8_LAS float*)131072;
        const int ca0 = u.pn * 128 + wc * 32 + 8 * fq;
        const int cpos = wc * 32 + 8 * fq;
        int tokv[2][4];
        { const int* tm = tokmap + 254 * u.pm + 64 * wr + fr;
#pragma unroll
          for (int ai = 0; ai < 2; ++ai)
#pragma unroll
              for (int m = 0; m < 4; ++m) tokv[ai][m] = tm[128 * ai + 16 * m]; }
#pragma unroll
        for (int ai = 0; ai < 2; ++ai) { const int gi = 2 * ai + wr;
#pragma unroll
            for (int bj = 0; bj < 2; ++bj)
#pragma unroll
                for (int n = 0; n < 2; ++n) {
                    if (fr == 0)  *(PG8_LAS f32x4*)(xb + (gi * 2 + 0) * 256 + 128 * bj + cpos + 4 * n) = acc[ai][bj][0][n];
                    if (fr == 15) *(PG8_LAS f32x4*)(xb + (gi * 2 + 1) * 256 + 128 * bj + cpos + 4 * n) = acc[ai][bj][3][n]; } }
        asm volatile("s_waitcnt lgkmcnt(0)" ::: "memory"); __builtin_amdgcn_s_barrier(); asm volatile("" ::: "memory");
#pragma unroll
        for (int ai = 0; ai < 2; ++ai) {
            const int gi = 2 * ai + wr;
#pragma unroll
            for (int n = 0; n < 2; ++n) {
                const int ca = ca0 + 4 * n;
                f32x4 w0[2], w1[2], w2[2], bb[2];
#pragma unroll
                for (int bj = 0; bj < 2; ++bj) { const int c = ca + bj * DFF; w0[bj] = *(const f32x4*)(cw + c); w1[bj] = *(const f32x4*)(cw + NUP + c); w2[bj] = *(const f32x4*)(cw + 2 * NUP + c); bb[bj] = *(const f32x4*)(cb + c); }
#pragma unroll
                for (int m = 0; m < 4; ++m) {
                    f32x4 cv[2];
#pragma unroll
                    for (int bj = 0; bj < 2; ++bj) {
                        const f32x4 cur = acc[ai][bj][m][n]; f32x4 prv, nxt;
                        f32x4 eprev = {0.f, 0.f, 0.f, 0.f}, enext = {0.f, 0.f, 0.f, 0.f};
                        if (m == 0 && gi > 0) eprev = *(const PG8_LAS f32x4*)(xb + ((gi - 1) * 2 + 1) * 256 + 128 * bj + cpos + 4 * n);
                        if (m == 3 && gi < 3) enext = *(const PG8_LAS f32x4*)(xb + ((gi + 1) * 2 + 0) * 256 + 128 * bj + cpos + 4 * n);
#pragma unroll
                        for (int j = 0; j < 4; ++j) {
                            float p = dpp_shr1(cur[j]), q = dpp_shl1(cur[j]);
                            if (m > 0) { const float e = dpp_mirror(acc[ai][bj][m - 1][n][j]); if (fr == 0) p = e; }
                            else { if (fr == 0) p = eprev[j]; }
                            if (m < 3) { const float e = dpp_mirror(acc[ai][bj][m + 1][n][j]); if (fr == 15) q = e; }
                            else { if (fr == 15) q = enext[j]; }
                            prv[j] = p; nxt[j] = q; }
                        cv[bj] = bb[bj] + w0[bj] * prv + w1[bj] * cur + w2[bj] * nxt;
                    }
                    const int R = 64 * gi + 16 * m + fr;
                    const int tok = tokv[ai][m];
                    if (R >= 1 && R <= 254 && tok >= 0) {
                        u32x2 w; w.x = cvt_pk_bf16(gelu_tanh_(cv[0][0]) * cv[1][0], gelu_tanh_(cv[0][1]) * cv[1][1]); w.y = cvt_pk_bf16(gelu_tanh_(cv[0][2]) * cv[1][2], gelu_tanh_(cv[0][3]) * cv[1][3]);
                        *(u32x2*)(act + (size_t)tok * DFF + ca) = w; }
                }
            }
        }
    }
};

template <class Epi, class Sched, bool ALIGN_EPI = false, bool SP2 = false, bool CONVA = false, bool DUAL = false>
__device__ __forceinline__ void gemm_phase(PG8_LAS unsigned char* lds, const Gemm g, const Sched& S, const Epi& E) {
    int tid_ = threadIdx.x; asm volatile("" : "+v"(tid_));
    const int tid = tid_, wid = __builtin_amdgcn_readfirstlane(tid >> 6), lane = tid & 63, wr = wid >> 2, wc = wid & 3, fr = lane & 15, fq = lane >> 4;
    const int K = g.K, nt = K / BK;
    unsigned voffA[2], voffB[2];
#pragma unroll
    for (int i = 0; i < 2; ++i) { int R, C; stage_rc(tid * 16 + i * 8192, R, C); const int Rb = Epi::PERM ? ((R & ~31) + perm32(R & 31)) : R;
        voffA[i] = (unsigned)(R * K + C) * 2u; voffB[i] = (unsigned)(Rb * K + C) * 2u; }
    const size_t kstep = (size_t)(BK * 2);
    const size_t hstepB = (size_t)HALF * K * 2, hstepA = hstepB;
    const size_t tstepB = 2 * hstepB, tstepA = CONVA ? (size_t)254 * K * 2 : tstepB;
    const unsigned ldsw = (unsigned)wid * 1024u;
    const int aoff = lds_byte(wr * 64 + fr, fq * 8), boff = lds_byte(wc * 32 + fr, fq * 8);
#define PG8_SA(b, h) (((b) * 2 + (h)) * HTB)
#define PG8_SB(b, h) ((4 + (b) * 2 + (h)) * HTB)
#define PG8_STAGE(bufoff, gbase, voff) do { _Pragma("unroll") for (int _i = 0; _i < 2; ++_i) \
        __builtin_amdgcn_global_load_lds((const unsigned*)((const char*)(gbase) + (voff)[_i]), (PG8_LAS unsigned*)(lds + (bufoff) + ldsw + _i * 8192), 16, 0, 0); } while (0)
#define PG8_LDA(dst, b, h) do { _Pragma("unroll") for (int m = 0; m < 4; ++m) _Pragma("unroll") for (int k = 0; k < 2; ++k) dst[m][k] = *(const PG8_LAS bf16x8*)(lds + PG8_SA(b, h) + aoff + m * 2048 + k * 1024); } while (0)
#define PG8_LDB(dst, b, h) do { _Pragma("unroll") for (int n = 0; n < 2; ++n) _Pragma("unroll") for (int k = 0; k < 2; ++k) dst[n][k] = *(const PG8_LAS bf16x8*)(lds + PG8_SB(b, h) + boff + n * 2048 + k * 1024); } while (0)
#define PG8_MMA(ai, bj, At, Bt) do { __builtin_amdgcn_s_setprio(1); _Pragma("unroll") for (int m = 0; m < 4; ++m) _Pragma("unroll") for (int n = 0; n < 2; ++n) _Pragma("unroll") for (int k = 0; k < 2; ++k) \
        acc[ai][bj][m][n] = __builtin_amdgcn_mfma_f32_16x16x32_bf16(Bt[n][k], At[m][k], acc[ai][bj][m][n], 0, 0, 0); __builtin_amdgcn_s_setprio(0); } while (0)
#define PG8_WAIT_V(n) asm volatile("s_waitcnt vmcnt(" #n ")" ::: "memory")
#define PG8_WAIT_L(n) asm volatile("s_waitcnt lgkmcnt(" #n ")" ::: "memory")
#define PG8_BAR __builtin_amdgcn_s_barrier()
#define PG8_SCHED __builtin_amdgcn_sched_barrier(0)
    Unit cur, nxt; int ui = 0;
    if (!S.next(0, cur)) return;
    f32x4 acc[2][2][4][2];
#pragma unroll
    for (int a = 0; a < 2; ++a)
#pragma unroll
        for (int b = 0; b < 2; ++b)
#pragma unroll
            for (int m = 0; m < 4; ++m)
#pragma unroll
                for (int n = 0; n < 2; ++n) acc[a][b][m][n] = (f32x4){0.f, 0.f, 0.f, 0.f};
    bf16x8 At[4][2], B0[2][2], B1[2][2];
    const char* cA = (const char*)((DUAL && cur.sel) ? g.A2 : g.A) + (size_t)cur.pm * tstepA; const char* cB = (const char*)((DUAL && cur.sel) ? g.Bt2 : g.Bt) + (size_t)cur.pn * tstepB;
    S.a_ready(cur);
    if constexpr (SP2) {
        PG8_STAGE(PG8_SB(0, 0), cB, voffB); PG8_STAGE(PG8_SB(0, 1), cB + hstepB, voffB); PG8_STAGE(PG8_SA(0, 0), cA, voffA); PG8_STAGE(PG8_SA(0, 1), cA + hstepA, voffA);
        if (wr == 1) PG8_BAR;
        PG8_WAIT_V(2); PG8_BAR;
        PG8_STAGE(PG8_SB(1, 0), cB + kstep, voffB); PG8_STAGE(PG8_SA(1, 0), cA + kstep, voffA); PG8_STAGE(PG8_SB(1, 1), cB + hstepB + kstep, voffB);
        PG8_WAIT_V(6); PG8_BAR;
    } else {
        PG8_STAGE(PG8_SB(0, 0), cB, voffB); PG8_STAGE(PG8_SA(0, 0), cA, voffA); PG8_STAGE(PG8_SB(0, 1), cB + hstepB, voffB); PG8_STAGE(PG8_SA(0, 1), cA + hstepA, voffA);
        if (wr == 1) PG8_BAR;
        PG8_WAIT_V(4); PG8_BAR;
        PG8_STAGE(PG8_SB(1, 0), cB + kstep, voffB); PG8_STAGE(PG8_SA(1, 0), cA + kstep, voffA); PG8_STAGE(PG8_SB(1, 1), cB + hstepB + kstep, voffB);
        PG8_WAIT_V(6); PG8_BAR;
    }
    for (;;) {
        const bool has_next = S.next(ui + 1, nxt);
        const char* nA = has_next ? (const char*)((DUAL && nxt.sel) ? g.A2 : g.A) + (size_t)nxt.pm * tstepA : cA; const char* nB = has_next ? (const char*)((DUAL && nxt.sel) ? g.Bt2 : g.Bt) + (size_t)nxt.pn * tstepB : cB;
        for (int t = 0; t < nt; t += 2) {
            const bool last = (t == nt - 2);
            const char* a1 = cA + (size_t)(t + 1) * kstep;
            const char* a2 = last ? nA : cA + (size_t)(t + 2) * kstep; const char* b2 = last ? nB : cB + (size_t)(t + 2) * kstep;
            const char* a3 = a2 + kstep; const char* b3 = b2 + kstep;
            if (last && has_next) S.a_ready(nxt);
            if constexpr (SP2) {
            PG8_LDB(B0, 0, 0); PG8_LDB(B1, 0, 1); PG8_SCHED; PG8_LDA(At, 0, 0); PG8_STAGE(PG8_SA(1, 1), a1 + hstepA, voffA);
            PG8_WAIT_V(8); PG8_WAIT_L(0); PG8_BAR; PG8_MMA(0, 0, At, B0); PG8_MMA(0, 1, At, B1); PG8_BAR; PG8_SCHED;
            PG8_LDA(At, 0, 1); PG8_STAGE(PG8_SB(0, 0), b2, voffB); PG8_STAGE(PG8_SB(0, 1), b2 + hstepB, voffB); PG8_STAGE(PG8_SA(0, 0), a2, voffA);
            PG8_WAIT_V(8); PG8_WAIT_L(0); PG8_BAR; PG8_MMA(1, 0, At, B0); PG8_MMA(1, 1, At, B1); PG8_BAR; PG8_SCHED;
            PG8_LDB(B0, 1, 0); PG8_LDB(B1, 1, 1); PG8_SCHED; PG8_LDA(At, 1, 0); PG8_STAGE(PG8_SA(0, 1), a2 + hstepA, voffA);
            PG8_WAIT_V(8); PG8_WAIT_L(0); PG8_BAR; PG8_MMA(0, 0, At, B0); PG8_MMA(0, 1, At, B1); PG8_BAR; PG8_SCHED;
            PG8_LDA(At, 1, 1); PG8_STAGE(PG8_SB(1, 0), b3, voffB); PG8_STAGE(PG8_SB(1, 1), b3 + hstepB, voffB); PG8_STAGE(PG8_SA(1, 0), a3, voffA);
            PG8_WAIT_V(8); PG8_WAIT_L(0); PG8_BAR; PG8_MMA(1, 0, At, B0); PG8_MMA(1, 1, At, B1); PG8_BAR; PG8_SCHED;
            } else {
            PG8_LDB(B0, 0, 0); PG8_SCHED; PG8_LDA(At, 0, 0); PG8_STAGE(PG8_SA(1, 1), a1 + hstepA, voffA);
            PG8_WAIT_L(8); PG8_BAR; PG8_WAIT_L(0); PG8_MMA(0, 0, At, B0); PG8_BAR; PG8_SCHED;
            PG8_LDB(B1, 0, 1); PG8_STAGE(PG8_SB(0, 0), b2, voffB);
            PG8_BAR; PG8_WAIT_L(0); PG8_MMA(0, 1, At, B1); PG8_BAR;
            PG8_LDA(At, 0, 1); PG8_STAGE(PG8_SA(0, 0), a2, voffA);
            PG8_BAR; PG8_WAIT_L(0); PG8_MMA(1, 0, At, B0); PG8_BAR; PG8_SCHED;
            PG8_STAGE(PG8_SB(0, 1), b2 + hstepB, voffB);
            PG8_WAIT_V(6); PG8_BAR; PG8_MMA(1, 1, At, B1); PG8_BAR;
            PG8_LDB(B0, 1, 0); PG8_SCHED; PG8_LDA(At, 1, 0); PG8_STAGE(PG8_SA(0, 1), a2 + hstepA, voffA);
            PG8_WAIT_L(8); PG8_BAR; PG8_WAIT_L(0); PG8_MMA(0, 0, At, B0); PG8_BAR; PG8_SCHED;
            PG8_LDB(B1, 1, 1); PG8_STAGE(PG8_SB(1, 0), b3, voffB);
            PG8_BAR; PG8_WAIT_L(0); PG8_MMA(0, 1, At, B1); PG8_BAR;
            PG8_LDA(At, 1, 1); PG8_STAGE(PG8_SA(1, 0), a3, voffA);
            PG8_BAR; PG8_WAIT_L(0); PG8_MMA(1, 0, At, B0); PG8_BAR; PG8_SCHED;
            PG8_STAGE(PG8_SB(1, 1), b3 + hstepB, voffB);
            PG8_WAIT_V(6); PG8_BAR; PG8_MMA(1, 1, At, B1); PG8_BAR;
            }
        }
        if constexpr (ALIGN_EPI) { if (wr == 0) PG8_BAR; }
        if constexpr (DUAL) { if (cur.sel == 0) E.mid(acc, cur, wr, wc, fr, fq); else E(acc, cur, wr, wc, fr, fq); }
        else if constexpr (!Epi::AFTER_DRAIN) { E(acc, cur, wr, wc, fr, fq); S.done(cur); }
        if (!has_next) break;
        if (!(DUAL && cur.sel == 0)) {
#pragma unroll
        for (int a = 0; a < 2; ++a)
#pragma unroll
            for (int b = 0; b < 2; ++b)
#pragma unroll
                for (int m = 0; m < 4; ++m)
#pragma unroll
                    for (int n = 0; n < 2; ++n) acc[a][b][m][n] = (f32x4){0.f, 0.f, 0.f, 0.f};
        }
        cur = nxt; cA = nA; cB = nB; ++ui;
        if constexpr (ALIGN_EPI) { if (wr == 1) PG8_BAR; }
    }
    PG8_WAIT_V(0);
    if constexpr (!ALIGN_EPI) { if (wr == 0) PG8_BAR; }
    PG8_BAR;
    if constexpr (Epi::AFTER_DRAIN) { E.fused(acc, cur, wr, wc, fr, fq, lds, wid, lane); S.done(cur); }
#undef PG8_SA
#undef PG8_SB
#undef PG8_STAGE
#undef PG8_LDA
#undef PG8_LDB
#undef PG8_MMA
#undef PG8_WAIT_V
#undef PG8_WAIT_L
#undef PG8_BAR
#undef PG8_SCHED
}
}
namespace att {
using bf16 = __hip_bfloat16;
constexpr int D = 128, NW = 8, QBLK = 32, KVBLK = 64;
constexpr float SCALE = 0.088388347648318440f;
constexpr float THR = 8.f;
constexpr int LDQ = 1024, LDK = 256, LDO = 1024;
constexpr size_t SHM_V = KVBLK * D * 2, SHM_K = KVBLK * D * 2, SHM_ATTN = 2 * SHM_V + 2 * SHM_K + NW * 64 * 4;
using bf16x8 = __attribute__((ext_vector_type(8))) short;
using s16x4  = __attribute__((ext_vector_type(4))) short;
using f32x16 = __attribute__((ext_vector_type(16))) float;
using u32x4  = __attribute__((ext_vector_type(4))) unsigned;
#define KSWZ(row, colB) ((row) * 256 + ((colB) ^ (((row) & 7) << 4)))
#define SBAR() __builtin_amdgcn_sched_barrier(0)
__device__ __forceinline__ int crow(int r, int hi) { return (r & 3) + 8 * (r >> 2) + 4 * hi; }
__device__ __forceinline__ unsigned cvtpk(float lo, float hi) { unsigned r; asm volatile("v_cvt_pk_bf16_f32 %0, %1, %2" : "=v"(r) : "v"(lo), "v"(hi)); return r; }
template <bool WIN>
__device__ __forceinline__ void partialSM(f32x16& p0, f32x16& p1, float& m_reg, float& mn, float& alpha, int mb) {
  constexpr float C = SCALE * 1.4426950408889634f;
  if (WIN) {
#pragma unroll
    for (int r = 0; r < 16; ++r) { const int d0 = mb + (r & 3) + 8 * (r >> 2);
      if ((unsigned)(d0 + 128) > 256u) p0[r] = -1e30f;
      if ((unsigned)(d0 + 160) > 256u) p1[r] = -1e30f; }
  }
  float pmax = p0[0]; for (int r = 1; r < 16; ++r) pmax = fmaxf(pmax, p0[r]); for (int r = 0; r < 16; ++r) pmax = fmaxf(pmax, p1[r]);
  { auto rr = __builtin_amdgcn_permlane32_swap(__float_as_uint(pmax), __float_as_uint(pmax), false, false);
    pmax = fmaxf(__uint_as_float(rr[0]), __uint_as_float(rr[1])); }
  if (__builtin_expect(__all(pmax - m_reg <= THR / SCALE), 1)) { mn = m_reg; alpha = 1.f; }
  else { mn = fmaxf(m_reg, pmax); alpha = __builtin_amdgcn_exp2f((m_reg - mn) * C); m_reg = mn; }
  float mnC = -mn * C;
  for (int r = 0; r < 16; ++r) p0[r] = fmaf(p0[r], C, mnC); for (int r = 0; r < 16; ++r) p1[r] = fmaf(p1[r], C, mnC);
  for (int r = 0; r < 16; ++r) p0[r] = __builtin_amdgcn_exp2f(p0[r]);
}
__device__ __forceinline__ void finishSM(f32x16& p0, f32x16& p1, float alpha, float& l_reg, bf16x8& pa0, bf16x8& pa1, bf16x8& pa2, bf16x8& pa3) {
  for (int r = 0; r < 16; ++r) p1[r] = __builtin_amdgcn_exp2f(p1[r]);
  float ps = 0; for (int r = 0; r < 16; ++r) ps += p0[r]; for (int r = 0; r < 16; ++r) ps += p1[r];
  { auto rr = __builtin_amdgcn_permlane32_swap(__float_as_uint(ps), __float_as_uint(ps), false, false);
    ps = __uint_as_float(rr[0]) + __uint_as_float(rr[1]); }
  l_reg = l_reg * alpha + ps;
#define PK4(P, BASE, OUT) do { unsigned a0 = cvtpk(P[BASE + 0], P[BASE + 1]), a1 = cvtpk(P[BASE + 2], P[BASE + 3]);   \
    unsigned b0 = cvtpk(P[BASE + 4], P[BASE + 5]), b1 = cvtpk(P[BASE + 6], P[BASE + 7]);                              \
    auto r0 = __builtin_amdgcn_permlane32_swap(a0, b0, false, false); auto r1 = __builtin_amdgcn_permlane32_swap(a1, b1, false, false); \
    u32x4 w = {r0[0], r1[0], r0[1], r1[1]}; OUT = *reinterpret_cast<bf16x8*>(&w); } while (0)
  PK4(p0, 0, pa0); PK4(p0, 8, pa1); PK4(p1, 0, pa2); PK4(p1, 8, pa3);
#undef PK4
}
__device__ __forceinline__ void qkt(f32x16& p0, f32x16& p1, const bf16* Ks, const bf16x8* qr, int r32, int hi) {
  p0 = f32x16{}; p1 = f32x16{};
  for (int d0 = 0; d0 < 8; ++d0) { int cb = (d0 * 16 + hi * 8) * 2;
    bf16x8 b0 = *reinterpret_cast<const bf16x8*>((const char*)Ks + KSWZ(r32, cb));
    bf16x8 b1 = *reinterpret_cast<const bf16x8*>((const char*)Ks + KSWZ(32 + r32, cb));
    p0 = __builtin_amdgcn_mfma_f32_32x32x16_bf16(b0, qr[d0], p0, 0, 0, 0);
    p1 = __builtin_amdgcn_mfma_f32_32x32x16_bf16(b1, qr[d0], p1, 0, 0, 0); }
}
__device__ __forceinline__ int v_st(int k, int c) { const int kk = (k & ~0xC) | ((k & 4) << 1) | ((k & 8) >> 1); return ((kk >> 3) * 4 + (c >> 5)) * 512 + ((kk & 7) * 32 + (c & 31)) * 2; }
__device__ __forceinline__ int v_rd_base(int lane) { return ((lane & 3) << 3) | (((lane >> 2) & 3) << 6) | (((lane >> 4) & 1) << 5) | (((lane >> 5) & 1) << 8); }
constexpr int v_rd_off(int d0, int ks, int half) { return d0 * 512 + ks * 4096 + half * 2048; }
template <int OFF> __device__ __forceinline__ s16x4 tr_read(int vb) {
  s16x4 r; asm volatile("ds_read_b64_tr_b16 %0, %1 offset:%2" : "=&v"(r) : "v"(vb), "i"(OFF) : "memory"); return r;
}
template <int D0> __device__ __forceinline__ void pv_one(f32x16& od, int vb, bf16x8 pa0, bf16x8 pa1, bf16x8 pa2, bf16x8 pa3) {
  const s16x4 l0 = tr_read<v_rd_off(D0, 0, 0)>(vb), h0 = tr_read<v_rd_off(D0, 0, 1)>(vb), l1 = tr_read<v_rd_off(D0, 1, 0)>(vb), h1 = tr_read<v_rd_off(D0, 1, 1)>(vb);
  const s16x4 l2 = tr_read<v_rd_off(D0, 2, 0)>(vb), h2 = tr_read<v_rd_off(D0, 2, 1)>(vb), l3 = tr_read<v_rd_off(D0, 3, 0)>(vb), h3 = tr_read<v_rd_off(D0, 3, 1)>(vb);
  asm volatile("s_waitcnt lgkmcnt(0)" ::: "memory"); SBAR();
#define PK(L, H) (bf16x8){L[0], L[1], L[2], L[3], H[0], H[1], H[2], H[3]}
  od = __builtin_amdgcn_mfma_f32_32x32x16_bf16(pa0, PK(l0, h0), od, 0, 0, 0);
  od = __builtin_amdgcn_mfma_f32_32x32x16_bf16(pa1, PK(l1, h1), od, 0, 0, 0);
  od = __builtin_amdgcn_mfma_f32_32x32x16_bf16(pa2, PK(l2, h2), od, 0, 0, 0);
  od = __builtin_amdgcn_mfma_f32_32x32x16_bf16(pa3, PK(l3, h3), od, 0, 0, 0);
#undef PK
}
__device__ __forceinline__ void pv_d0(f32x16* o, int vb, bf16x8 pa0, bf16x8 pa1, bf16x8 pa2, bf16x8 pa3) {
  pv_one<0>(o[0], vb, pa0, pa1, pa2, pa3); pv_one<1>(o[1], vb, pa0, pa1, pa2, pa3); pv_one<2>(o[2], vb, pa0, pa1, pa2, pa3); pv_one<3>(o[3], vb, pa0, pa1, pa2, pa3);
}
template <bool WIN, int SDEPTH>
__device__ __forceinline__ void attn_unit(const bf16* __restrict__ Qb, const bf16* __restrict__ Kh, const bf16* __restrict__ Vh, bf16* __restrict__ Ob, int NT, char* lds, int dk0, float sink) {
  int tid_ = threadIdx.x; asm volatile("" : "+v"(tid_));
  const int tid = tid_, wid = tid >> 6, lane = tid & 63, r32 = lane & 31, hi = lane >> 5;
  bf16* V_lds = (bf16*)lds; bf16* K_lds = (bf16*)(lds + 2 * SHM_V);
  float* ws = (float*)(lds + 2 * SHM_V + 2 * SHM_K) + wid * 64; float* li_l = ws; float* al_l = ws + 32;
  float m_reg = WIN ? sink * (1.0f / SCALE) : -1e30f, l_reg = WIN ? 1.f : 0.f; f32x16 o[4] = {}; bf16x8 qr[8];
  const int mb0 = dk0 + 4 * hi - (wid * QBLK + r32);
  const bf16* Qw = Qb + (long)(wid * QBLK + r32) * LDQ + hi * 8;
#pragma unroll
  for (int d0 = 0; d0 < 8; ++d0) qr[d0] = *reinterpret_cast<const bf16x8*>(Qw + d0 * 16);
  const int sr = tid >> 4, sc = (tid & 15) * 8, vst0 = v_st(sr, sc), vst1 = v_st(32 + sr, sc);
  const int vb0 = (int)(uintptr_t)V_lds + v_rd_base(lane);
  struct { bf16x8 vs0, vs1, ks0, ks1; } sr_[SDEPTH];
#define SLOAD(i, k0) do { sr_[i].vs0 = *reinterpret_cast<const bf16x8*>(&Vh[(long)((k0) + sr) * LDK + sc]); sr_[i].vs1 = *reinterpret_cast<const bf16x8*>(&Vh[(long)((k0) + 32 + sr) * LDK + sc]); \
    sr_[i].ks0 = *reinterpret_cast<const bf16x8*>(&Kh[(long)((k0) + sr) * LDK + sc]); sr_[i].ks1 = *reinterpret_cast<const bf16x8*>(&Kh[(long)((k0) + 32 + sr) * LDK + sc]); } while (0)
#define SWRITE(b, i) do { *(bf16x8*)((char*)V_lds + (b) * SHM_V + vst0) = sr_[i].vs0;          \
    *(bf16x8*)((char*)V_lds + (b) * SHM_V + vst1) = sr_[i].vs1; int kc = sc * 2;               \
    *(bf16x8*)((char*)K_lds + (b) * SHM_K + KSWZ(sr, kc)) = sr_[i].ks0;                       \
    *(bf16x8*)((char*)K_lds + (b) * SHM_K + KSWZ(32 + sr, kc)) = sr_[i].ks1; } while (0)
#define SWAIT() do { if constexpr (SDEPTH == 2) asm volatile("s_waitcnt vmcnt(4)" ::: "memory"); else asm volatile("s_waitcnt vmcnt(0)" ::: "memory"); } while (0)
#define RESC(a) do { if (__any((a) < 1.f)) { if (hi == 0) al_l[r32] = (a); asm volatile("s_waitcnt lgkmcnt(0)" ::: "memory"); \
    for (int d = 0; d < 4; ++d) for (int r = 0; r < 16; ++r) o[d][r] *= al_l[crow(r, hi)]; } } while (0)
  f32x16 pA0, pA1, pB0, pB1; float mnA, mnB, alA, alB; bf16x8 pa0, pa1, pa2, pa3;
  const int wq = __builtin_amdgcn_readfirstlane(wid) * QBLK;
#define NEED(j) (!WIN || ((64 * (j) + dk0 + 63 >= wq - 128) && (64 * (j) + dk0 <= wq + QBLK - 1 + 128)))
#define QKT(P0, P1, Ks, j) do { if (NEED(j)) qkt(P0, P1, Ks, qr, r32, hi); else { _Pragma("unroll") for (int r_ = 0; r_ < 16; ++r_) { P0[r_] = -1e30f; P1[r_] = -1e30f; } } } while (0)
#define PV(vb, j) do { if (NEED(j)) pv_d0(o, vb, pa0, pa1, pa2, pa3); } while (0)
  constexpr int SE = 0, SO = SDEPTH - 1;
  SLOAD(SE, 0); asm volatile("s_waitcnt vmcnt(0)" ::: "memory"); SWRITE(0, SE); __syncthreads();
  QKT(pA0, pA1, K_lds, 0); partialSM<WIN>(pA0, pA1, m_reg, mnA, alA, mb0);
  SLOAD(SO, KVBLK); if constexpr (SDEPTH == 2) { if (2 < NT) SLOAD(SE, 2 * KVBLK); }
  SWAIT(); SWRITE(1, SO); __syncthreads();
  for (int j = 1; j + 1 < NT; j += 2) {
    SBAR(); QKT(pB0, pB1, (bf16*)((char*)K_lds + SHM_K), j);
    finishSM(pA0, pA1, alA, l_reg, pa0, pa1, pa2, pa3); SBAR();
    SLOAD(SO, (j + SDEPTH) * KVBLK); SBAR();
    PV(vb0, j - 1);
    __syncthreads(); SWAIT(); SWRITE(0, SE);
    partialSM<WIN>(pB0, pB1, m_reg, mnB, alB, mb0 + 64 * j);
    RESC(alB); __syncthreads();
    SBAR(); QKT(pA0, pA1, K_lds, j + 1);
    finishSM(pB0, pB1, alB, l_reg, pa0, pa1, pa2, pa3); SBAR();
    if (SDEPTH == 1 || j + 3 < NT) SLOAD(SE, (j + 1 + SDEPTH) * KVBLK); SBAR();
    PV(vb0 + (int)SHM_V, j);
    __syncthreads(); SWAIT(); SWRITE(1, SO);
    partialSM<WIN>(pA0, pA1, m_reg, mnA, alA, mb0 + 64 * (j + 1));
    RESC(alA); __syncthreads();
  }
  SBAR(); QKT(pB0, pB1, (bf16*)((char*)K_lds + SHM_K), NT - 1);
  finishSM(pA0, pA1, alA, l_reg, pa0, pa1, pa2, pa3); SBAR();
  PV(vb0, NT - 2); partialSM<WIN>(pB0, pB1, m_reg, mnB, alB, mb0 + 64 * (NT - 1));
  __syncthreads(); RESC(alB);
  finishSM(pB0, pB1, alB, l_reg, pa0, pa1, pa2, pa3); SBAR();
  PV(vb0 + (int)SHM_V, NT - 1);
  if (hi == 0) li_l[r32] = l_reg; asm volatile("s_waitcnt lgkmcnt(0)" ::: "memory");
  float rli[16];
#pragma unroll
  for (int r = 0; r < 16; ++r) rli[r] = __builtin_amdgcn_rcpf(li_l[crow(r, hi)]);
  bf16* Ow = Ob + (long)(wid * QBLK) * LDO;
#pragma unroll
  for (int r = 0; r < 16; ++r) { int orow = crow(r, hi);
    for (int d0 = 0; d0 < 4; ++d0) Ow[(long)orow * LDO + d0 * 32 + r32] = __float2bfloat16(o[d0][r] * rli[r]); }
  asm volatile("s_waitcnt lgkmcnt(0)" ::: "memory");
#undef NEED
#undef QKT
#undef PV
#undef SLOAD
#undef SWRITE
#undef SWAIT
#undef RESC
}
#undef KSWZ
#undef SBAR
}

#ifndef SD_DENSE
#define SD_DENSE 2
#endif
#ifndef SD_WIN
#define SD_WIN 1
#endif
#ifndef WGM_P1
#define WGM_P1 4
#endif
#ifndef WGM_P3
#define WGM_P3 4
#endif
#ifndef WGM_P3C
#define WGM_P3C 4
#endif
#ifndef WGM_P4
#define WGM_P4 4
#endif
#ifndef WGM_P5
#define WGM_P5 4
#endif
#ifndef ROWS_P0
#define ROWS_P0 2
#endif
#ifndef ROWS_P6
#define ROWS_P6 2
#endif
#ifndef REP_PHASE
#define REP_PHASE -1
#endif
#define LAS __attribute__((address_space(3)))
typedef unsigned short bf16r;
typedef unsigned v4u __attribute__((ext_vector_type(4)));
typedef unsigned v2u __attribute__((ext_vector_type(2)));
typedef float v4f __attribute__((ext_vector_type(4)));
constexpr int NWAVES = 8;
__device__ __forceinline__ unsigned f2bf(float f) { unsigned u = __builtin_bit_cast(unsigned, f); return (u + 0x7fffu + ((u >> 16) & 1u)) >> 16; }
__device__ __forceinline__ unsigned pk2(float lo, float hi) { return f2bf(lo) | (f2bf(hi) << 16); }
__device__ __forceinline__ float wave_sum(float v) {
#pragma unroll
    for (int o = 1; o < 64; o <<= 1) v += __shfl_xor(v, o);
    return v;
}
__device__ __forceinline__ int map_win(int c) {
    if (c < 1280) { const int d = c & 127; const int p = 32 * (2 * (d >> 6) + ((d >> 4) & 1)) + 8 * ((d >> 2) & 3) + 4 * ((d >> 5) & 1) + (d & 3); return (c & ~127) + p; }
    if (c >= 1536 && c < 2816) { const int d = c & 127; const int p = 32 * ((d >> 4) & 3) + 8 * ((d >> 2) & 3) + 4 * (d >> 6) + (d & 3); return (c & ~127) + p; }
    return c;
}
__device__ __forceinline__ int map_wup(int c) { return c < DFF ? ((c >> 7) * 256 + (c & 127)) : (((c - DFF) >> 7) * 256 + 128 + ((c - DFF) & 127)); }
template <int MAP>
__device__ __forceinline__ void transpose_item(const float* W, int K, int N, bf16r* WT, LAS float* scr, int item, int lane) {
    const int nblk = N / 32, kb = item / nblk, nb = item % nblk, k0 = 64 * kb, n0 = 32 * nb;
#pragma unroll 8
    for (int i = 0; i < 32; ++i) { const int kk = 2 * i + (lane >> 5); scr[kk * 33 + (lane & 31)] = __builtin_nontemporal_load(W + (size_t)(k0 + kk) * N + n0 + (lane & 31)); }
    asm volatile("s_waitcnt lgkmcnt(0)" ::: "memory");
    const int c = lane & 7;
#pragma unroll
    for (int j = 0; j < 4; ++j) { const int n = (lane >> 3) + 8 * j; const LAS float* s = scr + (8 * c) * 33 + n;
        v4u o; o.x = pk2(s[0 * 33], s[1 * 33]); o.y = pk2(s[2 * 33], s[3 * 33]); o.z = pk2(s[4 * 33], s[5 * 33]); o.w = pk2(s[6 * 33], s[7 * 33]);
        const int src = n0 + n; const int dst = MAP == 1 ? map_win(src) : (MAP == 2 ? map_wup(src) : src);
        *(v4u*)(WT + (size_t)dst * K + k0 + 8 * c) = o; }
    asm volatile("s_waitcnt lgkmcnt(0)" ::: "memory");
}
__device__ __forceinline__ const float* xrow_ptr(const float* xp, const float* xs, int tok) { return tok < NPROMPT ? xp + (size_t)tok * DM : xs + (size_t)(tok - NPROMPT) * DM; }

#define XB_TMO      128
#define XB_XCNT(j)  (256  + 64 * (j))
#define XB_XSUB(j)  (1280 + 64 * (j))
#define XB_XGEN(j)  (2304 + 64 * (j))
#define XB_TOP      3328
#define XB_TOPGEN   3392
#define XCD_BAR_WORDS 3456
#define XB_SPIN_CAP (1u << 22)

__device__ __forceinline__ unsigned xb_ld(unsigned* p)              { return __hip_atomic_load(p, __ATOMIC_RELAXED, __HIP_MEMORY_SCOPE_AGENT); }
__device__ __forceinline__ unsigned xb_add(unsigned* p, unsigned v) { return __hip_atomic_fetch_add(p, v, __ATOMIC_RELAXED, __HIP_MEMORY_SCOPE_AGENT); }
__device__ __forceinline__ unsigned xb_xcc_id() { return (unsigned)__builtin_amdgcn_s_getreg((3 << 11) | 20) & 0xFu; }
#define XB_SPIN(cond, bar) do { unsigned _sp = 0; while (cond) { __builtin_amdgcn_s_sleep(1); \
    if ((++_sp & 255u) == 0u) { if (xb_ld(&(bar)[XB_TMO])) break; if (_sp > XB_SPIN_CAP) { atomicAdd(&(bar)[XB_TMO], 1u); break; } } } } while (0)

struct XcdBarrier {
    unsigned* bar; unsigned x;
    volatile LAS unsigned* st;
};

__device__ __forceinline__ XcdBarrier xcd_barrier_post(unsigned* bar, volatile LAS unsigned* st) {
    XcdBarrier b; b.bar = bar; b.x = xb_xcc_id(); b.st = st;
    if (threadIdx.x == 0) (void)xb_add(&bar[XB_XCNT(b.x)], 1u);
    return b;
}
__device__ __forceinline__ void xcd_barrier_complete(unsigned* bar, unsigned x, unsigned& nloc, unsigned& nx) {
    const unsigned G = gridDim.x * gridDim.y * gridDim.z;
    unsigned sum, cnt, mine, sp = 0u;
    for (;;) {
        sum = 0u; cnt = 0u; mine = 0u;
#pragma unroll
        for (unsigned j = 0; j < 16; ++j) { const unsigned c = xb_ld(&bar[XB_XCNT(j)]); sum += c; cnt += (c > 0u) ? 1u : 0u; mine = (j == x) ? c : mine; }
        if (sum == G) break;
        __builtin_amdgcn_s_sleep(1);
        if ((++sp & 255u) == 0u) { if (xb_ld(&bar[XB_TMO])) break; if (sp > XB_SPIN_CAP) { atomicAdd(&bar[XB_TMO], 1u); break; } }
    }
    nloc = mine > 0u ? mine : 1u; nx = cnt > 0u ? cnt : 1u;
}

__device__ __forceinline__ void xcd_barrier(const XcdBarrier& b) {
    asm volatile("s_waitcnt vmcnt(0)" ::: "memory");
    __syncthreads();
    if (threadIdx.x == 0) {
        unsigned* bar = b.bar;
        __builtin_amdgcn_s_waitcnt(0);
        unsigned nloc = b.st[0], nx = b.st[1];
        if (nloc == 0u) { xcd_barrier_complete(bar, b.x, nloc, nx); b.st[0] = nloc; b.st[1] = nx; }
        const unsigned old = xb_add(&bar[XB_XSUB(b.x)], 1u);
        const unsigned gen = old / nloc;
        if (old + 1u == (gen + 1u) * nloc) {
            __builtin_amdgcn_fence(__ATOMIC_RELEASE, "agent");
            asm volatile("s_waitcnt vmcnt(0)" ::: "memory");
            const unsigned og = xb_add(&bar[XB_TOP], 1u);
            const unsigned tg = og / nx;
            if (og + 1u == (tg + 1u) * nx) xb_add(&bar[XB_TOPGEN], 1u);
            else XB_SPIN(xb_ld(&bar[XB_TOPGEN]) == tg, bar);
            __builtin_amdgcn_fence(__ATOMIC_ACQUIRE, "agent");
            xb_add(&bar[XB_XGEN(b.x)], 1u);
            asm volatile("s_waitcnt vmcnt(0)" ::: "memory");
        } else {
            XB_SPIN(xb_ld(&bar[XB_XGEN(b.x)]) == gen, bar);
            __builtin_amdgcn_fence(__ATOMIC_ACQUIRE, "agent");
            asm volatile("s_waitcnt vmcnt(0)" ::: "memory");
        }
    }
    __syncthreads();
}

struct Args { const float* in[17]; float* out; unsigned char* ws; double invf_t[64]; double invf_ax[32]; };

__global__ void __launch_bounds__(NWAVES * 64, 2) mega_fwd(Args args) {
    extern __shared__ __attribute__((aligned(16))) unsigned char lds[];
    cg::grid_group grid = cg::this_grid();
    const int tid = threadIdx.x, lane = tid & 63, wave = __builtin_amdgcn_readfirstlane(tid >> 6);
    const int G = gridDim.x, bx = blockIdx.x;
    const int vcu = (G % 8 == 0) ? (bx % 8) * (G / 8) + bx / 8 : bx;
    const int gw = vcu * NWAVES + wave, NGW = G * NWAVES;
    unsigned char* ws = args.ws;
    const float* x_prompt = args.in[0]; const float* x_sample = args.in[1];
    const float* norm_pre_mix = args.in[2]; const float* w_in = args.in[3]; const float* q_norm_a = args.in[4]; const float* k_norm_a = args.in[5];
    const float* sink_b = args.in[6]; const float* w_branch_a = args.in[7]; const float* w_branch_b = args.in[8]; const float* w_out = args.in[9];
    const float* norm_post_mix = args.in[10]; const float* norm_pre_ffn = args.in[11]; const float* w_up = args.in[12]; const float* conv_w = args.in[13];
    const float* conv_b = args.in[14]; const float* w_down = args.in[15]; const float* norm_post_ffn = args.in[16];
    float* out = args.out;
    bf16r* WinT = (bf16r*)(ws + WS_WIN); bf16r* WaT = (bf16r*)(ws + WS_WA); bf16r* WbT = (bf16r*)(ws + WS_WB); bf16r* WoutT = (bf16r*)(ws + WS_WOUT);
    bf16r* WupT = (bf16r*)(ws + WS_WUP); bf16r* WdownT = (bf16r*)(ws + WS_WDOWN);
    bf16r* Hb = (bf16r*)(ws + WS_H);

    unsigned* barw = (unsigned*)(ws + 65536);
    volatile LAS unsigned* bar_st = (volatile LAS unsigned*)((LAS unsigned char*)lds + 143360);
    if (bx == 0) for (int i = tid; i < XCD_BAR_WORDS; i += NWAVES * 64) barw[i] = 0u;
    if (tid < 2) bar_st[tid] = 0u;
    XcdBarrier xbar;
#define GRID_BAR() xcd_barrier(xbar)
#ifndef SKIP_0
    for (int rep_ = 0; rep_ < (REP_PHASE == 0 ? 2 : 1); ++rep_) {
        LAS float* scr = (LAS float*)((LAS unsigned char*)lds + wave * 16384);
        constexpr int I_IN = (DM / 64) * (NIN / 32), I_A = (1024 / 64) * (DM / 32), I_OUT = (DM / 64) * (DM / 32), I_UP = (DM / 64) * (NUP / 32), I_DN = (DFF / 64) * (DM / 32);
        constexpr int NITEMS = I_IN + 2 * I_A + I_OUT + I_UP;
        for (int it = gw; it < NITEMS; it += NGW) {
            int r = it;
            if (r < I_IN) { transpose_item<1>(w_in, DM, NIN, WinT, scr, r, lane); continue; } r -= I_IN;
            if (r < I_A) { transpose_item<0>(w_branch_a, 1024, DM, WaT, scr, r, lane); continue; } r -= I_A;
            if (r < I_A) { transpose_item<0>(w_branch_b, 1024, DM, WbT, scr, r, lane); continue; } r -= I_A;
            if (r < I_OUT) { transpose_item<0>(w_out, DM, DM, WoutT, scr, r, lane); continue; } r -= I_OUT;
            transpose_item<2>(w_up, DM, NUP, WupT, scr, r, lane);
        }
        float* cost = (float*)(ws + WS_COST); float* sint = (float*)(ws + WS_SINT); float* ax = (float*)(ws + WS_AX);
        for (int e = vcu * 512 + tid; e < 8192 * 64; e += G * 512) { const int t = e >> 6, i = e & 63; double a = (double)t * args.invf_t[i]; a -= floor(a); const float fr = (float)a;
            cost[e] = __builtin_amdgcn_cosf(fr); sint[e] = __builtin_amdgcn_sinf(fr); }
        for (int e = vcu * 512 + tid; e < 128 * 32 + 64 * 32; e += G * 512) {
            const bool isrow = e < 128 * 32; const int e2 = isrow ? e : e - 128 * 32; const int pos = e2 >> 5, i = e2 & 31;
            double a = (double)pos * args.invf_ax[i]; a -= floor(a); const float fr = (float)a;
            const float c = __builtin_amdgcn_cosf(fr), s = __builtin_amdgcn_sinf(fr);
            if (isrow) { ax[e2] = c; ax[4096 + e2] = s; } else { ax[8192 + e2] = c; ax[10240 + e2] = s; } }
        for (int e = vcu * 512 + tid; e < NPAD; e += G * 512) ((int*)(ws + WS_TOKMAP))[e] = pg8::conv_row_token(e);
        for (int m0 = gw; m0 < NTOK; m0 += ROWS_P0 * NGW) {
            v4f v[ROWS_P0][8];
#pragma unroll
            for (int r = 0; r < ROWS_P0; ++r) { const int m = m0 + r * NGW; if (m < NTOK) { const v4f* xr = (const v4f*)xrow_ptr(x_prompt, x_sample, m) + lane;
#pragma unroll
                for (int j = 0; j < 8; ++j) v[r][j] = __builtin_nontemporal_load(xr + 64 * j); } }
#pragma unroll
            for (int r = 0; r < ROWS_P0; ++r) { const int m = m0 + r * NGW; if (m >= NTOK) continue;
                float s = 0.f;
#pragma unroll
                for (int j = 0; j < 8; ++j) s += (v[r][j].x * v[r][j].x + v[r][j].y * v[r][j].y) + (v[r][j].z * v[r][j].z + v[r][j].w * v[r][j].w);
                const float rstd = 1.f / sqrtf(wave_sum(s) * (1.f / DM) + RMS_EPS);
                unsigned long long* o8 = (unsigned long long*)(Hb + (size_t)m * DM) + lane;
#pragma unroll
                for (int j = 0; j < 8; ++j) { const v4f g = *((const v4f*)norm_pre_mix + lane + 64 * j);
                    o8[64 * j] = (unsigned long long)pk2(v[r][j].x * rstd * g.x, v[r][j].y * rstd * g.y) | ((unsigned long long)pk2(v[r][j].z * rstd * g.z, v[r][j].w * rstd * g.w) << 32); } }
        }
    }
#endif
    grid.sync();
    xbar = xcd_barrier_post(barw, bar_st);

#ifdef EXTRA_SYNCS
    for (int q_ = 0; q_ < EXTRA_SYNCS; ++q_) grid.sync();
#endif
#ifndef SKIP_1
    for (int rep_ = 0; rep_ < (REP_PHASE == 1 ? 2 : 1); ++rep_) {
        pg8::Gemm g{Hb, WinT, NTOK, NIN, DM, nullptr, nullptr}; pg8::StaticOrder S; S.init(NTOK, NIN, G, bx, WGM_P1);
        pg8::EpiProj E{ws, q_norm_a, k_norm_a, (LAS float*)((LAS unsigned char*)lds + 131072)};
        pg8::gemm_phase<pg8::EpiProj, pg8::StaticOrder, true, true, false>((LAS unsigned char*)lds, g, S, E);
    }
#endif
    GRID_BAR();

#ifndef SKIP_3
    for (int rep_ = 0; rep_ < (REP_PHASE == 3 ? 2 : 1); ++rep_) {
        using abf = att::bf16;
        const abf* qA = (const abf*)(ws + WS_QA); const abf* kA = (const abf*)(ws + WS_KA); const abf* vA = (const abf*)(ws + WS_VA);
        const abf* qB = (const abf*)(ws + WS_QB); const abf* kB = (const abf*)(ws + WS_KB); const abf* vB = (const abf*)(ws + WS_VB);
        abf* oA = (abf*)(ws + WS_OA); abf* oB = (abf*)(ws + WS_OB);
#ifndef SKIP_DP
        for (int i = 0; i < 6; ++i) {
            size_t tok0, kr; int h, NT;
            if (i < 4) { const int u = vcu * 4 + i; const int bh = u >> 5, qb = u & 31, b = bh >> 3; h = bh & 7; kr = (size_t)b * 8192; tok0 = kr + qb * 256; NT = 128; }
            else { const int u = vcu * 2 + (i - 4); const int bh = u >> 3, qb = u & 7, b = bh >> 3; h = bh & 7; kr = (size_t)NPROMPT + (size_t)b * 2048; tok0 = kr + qb * 256; NT = 32; }
            att::attn_unit<false, SD_DENSE>(qA + tok0 * 1024 + h * 128, kA + kr * 256 + (h >> 2) * 128, vA + kr * 256 + (h >> 2) * 128, oA + tok0 * 1024 + h * 128, NT, (char*)lds, 0, 0.f); }
        for (int i = 0; i < 6; ++i) {
            const int u = vcu * 6 + i; const int tb = u >> 3, h = u & 7; const int t0 = tb * 256; int sbase, SL;
            if (t0 < NPROMPT) { sbase = t0 & ~8191; SL = 8192; } else { sbase = NPROMPT + ((t0 - NPROMPT) & ~2047); SL = 2048; }
            const int q0 = t0 - sbase; const int kt0 = q0 >= 128 ? q0 - 128 : 0; const int kt1 = (q0 + 384 <= SL) ? q0 + 384 : SL; const int NT = (kt1 - kt0) >> 6;
            const size_t kr = (size_t)sbase + kt0, tok0 = (size_t)t0;
            att::attn_unit<true, SD_WIN>(qB + tok0 * 1024 + h * 128, kB + kr * 256 + (h >> 2) * 128, vB + kr * 256 + (h >> 2) * 128, oB + tok0 * 1024 + h * 128, NT, (char*)lds, kt0 - q0, sink_b[h]); }
#endif
        __syncthreads();
    }
#endif
    GRID_BAR();

#ifndef SKIP_4
    for (int rep_ = 0; rep_ < (REP_PHASE == 4 ? 2 : 1); ++rep_) {
        pg8::PairOrder S; S.base.init(NTOK, DM, G, bx, WGM_P3);
        pg8::Gemm g{(const bf16r*)(ws + WS_OA), WaT, NTOK, DM, 1024, (const bf16r*)(ws + WS_OB), WbT};
        pg8::EpiGate2 E{(const bf16r*)(ws + WS_GA), (const bf16r*)(ws + WS_GB), (bf16r*)(ws + WS_MERGED)};
        pg8::gemm_phase<pg8::EpiGate2, pg8::PairOrder, true, true, false, true>((LAS unsigned char*)lds, g, S, E);
    }
#endif
    GRID_BAR();

#ifndef SKIP_5
    for (int rep_ = 0; rep_ < (REP_PHASE == 5 ? 2 : 1); ++rep_) {
        pg8::Gemm g{(const bf16r*)(ws + WS_MERGED), WoutT, NTOK, DM, DM, nullptr, nullptr}; pg8::StaticOrder S; S.init(NTOK, DM, G, bx, WGM_P3C);
        pg8::EpiBf16Plain E{(bf16r*)(ws + WS_MIX)};
        pg8::gemm_phase<pg8::EpiBf16Plain, pg8::StaticOrder, true, true, false>((LAS unsigned char*)lds, g, S, E);
    }
#endif
    GRID_BAR();

#ifndef SKIP_6
    {
        for (int P0 = gw; P0 < NPAD; P0 += 2 * NGW) {
            v4f mv[2][8], xv[2][8]; int tokr[2]; bool istok[2];
#pragma unroll
            for (int r = 0; r < 2; ++r) { const int P = P0 + r * NGW; istok[r] = false; tokr[r] = 0;
                if (P < NPAD) { const int tk = ((const int*)(ws + WS_TOKMAP))[P];
                    if (tk >= 0) { istok[r] = true; tokr[r] = tk;
                        const v2u* mrow = (const v2u*)((const bf16r*)(ws + WS_MIX) + (size_t)tokr[r] * DM) + lane; const v4f* xr = (const v4f*)xrow_ptr(x_prompt, x_sample, tokr[r]) + lane;
#pragma unroll
                        for (int j = 0; j < 8; ++j) { const v2u w = __builtin_nontemporal_load(mrow + 64 * j); mv[r][j] = (v4f){pg8::bf_lo(w.x), pg8::bf_hi(w.x), pg8::bf_lo(w.y), pg8::bf_hi(w.y)}; xv[r][j] = __builtin_nontemporal_load(xr + 64 * j); } } } }
#pragma unroll
            for (int r = 0; r < 2; ++r) { const int P = P0 + r * NGW; if (P >= NPAD) continue;
                unsigned long long* o8 = (unsigned long long*)(Hb + (size_t)P * DM) + lane;
                if (!istok[r]) {
#pragma unroll
                    for (int j = 0; j < 8; ++j) o8[64 * j] = 0ull;
                    continue; }
                unsigned long long* x1row = (unsigned long long*)(tokr[r] < X1_SPLIT ? ws + WS_X1A + (size_t)tokr[r] * (DM * 2) : ws + WS_X1B + (size_t)(tokr[r] - X1_SPLIT) * (DM * 2)) + lane;
                float s = 0.f;
#pragma unroll
                for (int j = 0; j < 8; ++j) s += (mv[r][j].x * mv[r][j].x + mv[r][j].y * mv[r][j].y) + (mv[r][j].z * mv[r][j].z + mv[r][j].w * mv[r][j].w);
                const float rstd = 1.f / sqrtf(wave_sum(s) * (1.f / DM) + RMS_EPS);
                float s2 = 0.f;
#pragma unroll
                for (int j = 0; j < 8; ++j) { const v4f g = *((const v4f*)norm_post_mix + lane + 64 * j); const v4f x1 = xv[r][j] + mv[r][j] * rstd * g; mv[r][j] = x1; __builtin_nontemporal_store((unsigned long long)pk2(x1.x, x1.y) | ((unsigned long long)pk2(x1.z, x1.w) << 32), x1row + 64 * j);
                    s2 += (x1.x * x1.x + x1.y * x1.y) + (x1.z * x1.z + x1.w * x1.w); }
                const float rstd2 = 1.f / sqrtf(wave_sum(s2) * (1.f / DM) + RMS_EPS);
#pragma unroll
                for (int j = 0; j < 8; ++j) { const v4f g = *((const v4f*)norm_pre_ffn + lane + 64 * j); const v4f x1 = mv[r][j];
                    o8[64 * j] = (unsigned long long)pk2(x1.x * rstd2 * g.x, x1.y * rstd2 * g.y) | ((unsigned long long)pk2(x1.z * rstd2 * g.z, x1.w * rstd2 * g.w) << 32); } }
        }
    }
#endif
    GRID_BAR();

#ifndef SKIP_7
    for (int rep_ = 0; rep_ < (REP_PHASE == 7 ? 2 : 1); ++rep_) {
        pg8::Gemm g{Hb, WupT, MT_UP * 256, NUP, DM, nullptr, nullptr}; pg8::StaticOrder S; S.init(MT_UP * 256, NUP, G, bx, WGM_P4);
        pg8::EpiConv E{conv_w, conv_b, (bf16r*)(ws + WS_ACT), (const int*)(ws + WS_TOKMAP)};
        pg8::gemm_phase<pg8::EpiConv, pg8::StaticOrder, P4_ALIGN, true, true>((LAS unsigned char*)lds, g, S, E);
        { constexpr int NU4 = MT_UP * (NUP / 256), I_DN4 = (DFF / 64) * (DM / 32);
          const int first_idle = NU4 % G, nidle = G - first_idle;
          int ln_ = lane, wv_ = wave; asm volatile("" : "+v"(ln_), "+s"(wv_));
          if (bx >= first_idle) { LAS float* scr = (LAS float*)((LAS unsigned char*)lds + wv_ * 16384);
              const float* wdn = *(const float* const*)((const char*)__builtin_amdgcn_kernarg_segment_ptr() + 15 * sizeof(void*));
              for (int it = (bx - first_idle) * NWAVES + wv_; it < I_DN4; it += nidle * NWAVES) transpose_item<0>(wdn, DFF, DM, (bf16r*)(ws + WS_WDOWN), scr, it, ln_); } }
    }
#endif
    GRID_BAR();

#ifndef SKIP_8
    for (int rep_ = 0; rep_ < (REP_PHASE == 8 ? 2 : 1); ++rep_) {
        pg8::Gemm g{(const bf16r*)(ws + WS_ACT), WdownT, NTOK, DM, DFF, nullptr, nullptr}; pg8::StaticOrder S; S.init(NTOK, DM, G, bx, WGM_P5);
        pg8::EpiBf16Plain E{Hb};
        pg8::gemm_phase<pg8::EpiBf16Plain, pg8::StaticOrder, true, true, false>((LAS unsigned char*)lds, g, S, E);
    }
#endif
    GRID_BAR();

#ifndef SKIP_9
    {
        for (int m0 = gw; m0 < NTOK; m0 += ROWS_P6 * NGW) {
            v4u fw[ROWS_P6][4]; v4u xw[ROWS_P6][4];
#pragma unroll
            for (int r = 0; r < ROWS_P6; ++r) { const int m = m0 + r * NGW; if (m < NTOK) { const v4u* fr_ = (const v4u*)(Hb + (size_t)m * DM) + lane; const v4u* xr_ = (const v4u*)(m < X1_SPLIT ? ws + WS_X1A + (size_t)m * (DM * 2) : ws + WS_X1B + (size_t)(m - X1_SPLIT) * (DM * 2)) + lane;
#pragma unroll
                for (int c = 0; c < 4; ++c) { fw[r][c] = __builtin_nontemporal_load(fr_ + 64 * c); xw[r][c] = __builtin_nontemporal_load(xr_ + 64 * c); } } }
#pragma unroll
            for (int r = 0; r < ROWS_P6; ++r) { const int m = m0 + r * NGW; if (m >= NTOK) continue;
                float f[4][8]; float s = 0.f;
#pragma unroll
                for (int c = 0; c < 4; ++c) { const v4u w = fw[r][c];
                    f[c][0] = pg8::bf_lo(w.x); f[c][1] = pg8::bf_hi(w.x); f[c][2] = pg8::bf_lo(w.y); f[c][3] = pg8::bf_hi(w.y); f[c][4] = pg8::bf_lo(w.z); f[c][5] = pg8::bf_hi(w.z); f[c][6] = pg8::bf_lo(w.w); f[c][7] = pg8::bf_hi(w.w);
#pragma unroll
                    for (int e = 0; e < 8; ++e) s += f[c][e] * f[c][e]; }
                const float rstd = 1.f / sqrtf(wave_sum(s) * (1.f / DM) + RMS_EPS);
                float* orow = out + (size_t)m * DM;
#pragma unroll
                for (int c = 0; c < 4; ++c) { const int e0 = 8 * lane + 512 * c;
                    const v4f g0 = *(const v4f*)(norm_post_ffn + e0), g1 = *(const v4f*)(norm_post_ffn + e0 + 4);
                    const v4u xq = xw[r][c]; v4f a0 = {pg8::bf_lo(xq.x), pg8::bf_hi(xq.x), pg8::bf_lo(xq.y), pg8::bf_hi(xq.y)}, a1 = {pg8::bf_lo(xq.z), pg8::bf_hi(xq.z), pg8::bf_lo(xq.w), pg8::bf_hi(xq.w)};
                    a0.x += f[c][0] * rstd * g0.x; a0.y += f[c][1] * rstd * g0.y; a0.z += f[c][2] * rstd * g0.z; a0.w += f[c][3] * rstd * g0.w;
                    a1.x += f[c][4] * rstd * g1.x; a1.y += f[c][5] * rstd * g1.y; a1.z += f[c][6] * rstd * g1.z; a1.w += f[c][7] * rstd * g1.w;
                    __builtin_nontemporal_store(a0, (v4f*)(orow + e0)); __builtin_nontemporal_store(a1, (v4f*)(orow + e0 + 4)); } }
        }
    }
#endif
}

extern "C" void kernel_launch(void* const* d_in, const int* in_sizes, int n_in, void* d_out, int out_size, void* d_ws, size_t ws_size, hipStream_t stream) {
    static int grid = 0;
    if (grid == 0) {
        if (n_in != 17 || ws_size < WS_END || out_size != NTOK * DM || in_sizes[0] != NPROMPT * DM) { fprintf(stderr, "kernel_launch: bad shapes n_in %d ws %zu out %d\n", n_in, ws_size, out_size); grid = -1; return; }
        int dev = 0, cus = 0, per_cu = 0;
        hipGetDevice(&dev);
        hipDeviceGetAttribute(&cus, hipDeviceAttributeMultiprocessorCount, dev);
        if (hipFuncSetAttribute((const void*)mega_fwd, hipFuncAttributeMaxDynamicSharedMemorySize, LDS_BYTES) != hipSuccess) { fprintf(stderr, "kernel_launch: hipFuncSetAttribute failed\n"); grid = -1; return; }
        if (hipOccupancyMaxActiveBlocksPerMultiprocessor(&per_cu, (const void*)mega_fwd, NWAVES * 64, LDS_BYTES) != hipSuccess || per_cu < 1) { fprintf(stderr, "kernel_launch: occupancy query says %d\n", per_cu); }
        (void)hipGetLastError();
        if (cus != 256) { fprintf(stderr, "kernel_launch: built for 256 CUs, found %d\n", cus); grid = -1; return; }
        grid = cus;
    }
    if (grid < 0) return;
    Args a{};
    for (int i = 0; i < 17; ++i) a.in[i] = (const float*)d_in[i];
    a.out = (float*)d_out; a.ws = (unsigned char*)d_ws;
    const double two_pi = 6.283185307179586476925286766559;
    for (int i = 0; i < 64; ++i) a.invf_t[i] = pow(10000.0, -(double)i / 64.0) / two_pi;
    for (int i = 0; i < 32; ++i) a.invf_ax[i] = pow(10000.0, -(double)i / 32.0) / two_pi;
    void* kargs[] = {&a};
    hipError_t e = hipLaunchCooperativeKernel((const void*)mega_fwd, dim3(grid), dim3(NWAVES * 64), kargs, LDS_BYTES, stream);
    if (e != hipSuccess) fprintf(stderr, "kernel_launch: cooperative launch failed: %s (grid %d)\n", hipGetErrorString(e), grid);
}
```

```cpp
#define SD_DENSE 1
#define SD_WIN 1
#define P4_ALIGN true
#define WGM_P4 6
#include <hip/hip_runtime.h>
#include <hip/hip_cooperative_groups.h>
#include <hip/hip_bf16.h>
#include <cstdio>
#include <cstdint>
#include <cmath>
namespace cg = cooperative_groups;

constexpr int NTOK = 49152, NPROMPT = 32768, DM = 2048, NIN = 7168, DFF = 5632, NUP = 11264;
constexpr int MT_UP = 194, NPAD = 254 * (MT_UP - 1) + 256 + 2;
constexpr size_t WS_TOKMAP = 131072;
constexpr float RMS_EPS = 1e-6f;
constexpr size_t MiB = 1u << 20;
constexpr size_t WS_COST = 1 * MiB, WS_SINT = 3 * MiB, WS_AX = 5 * MiB;
constexpr size_t WS_WIN = 6 * MiB, WS_WA = 34 * MiB, WS_WB = 38 * MiB, WS_WOUT = 42 * MiB, WS_WUP = 50 * MiB, WS_WDOWN = 94 * MiB;
constexpr size_t WS_SSQ = 116 * MiB;
constexpr size_t WS_H = 124 * MiB;
constexpr size_t WS_OA = 124 * MiB, WS_OB = 220 * MiB;
constexpr size_t WS_QA = 320 * MiB, WS_KA = 416 * MiB, WS_VA = 440 * MiB, WS_QB = 464 * MiB, WS_KB = 560 * MiB, WS_VB = 584 * MiB, WS_GA = 608 * MiB, WS_GB = 800 * MiB;
constexpr size_t WS_MIX = 512 * MiB;
constexpr size_t WS_X1A = 848 * MiB, WS_X1B = 6 * MiB; constexpr int X1_SPLIT = 45056;
constexpr size_t WS_MERGED = 320 * MiB, WS_ACT = 320 * MiB, WS_END = 1024 * MiB;
static_assert(WS_H + (size_t)NPAD * DM * 2 <= WS_QA && WS_ACT + (size_t)NTOK * DFF * 2 <= WS_END && WS_GB + (size_t)NTOK * DM * 2 <= WS_END, "ws map");
constexpr int LDS_BYTES = 147456;

namespace pg8 {
#define PG8_LAS __attribute__((address_space(3)))
typedef unsigned short bf16_t;
typedef short bf16x8 __attribute__((ext_vector_type(8)));
typedef float f32x4 __attribute__((ext_vector_type(4)));
typedef unsigned u32x4 __attribute__((ext_vector_type(4)));
constexpr int BM = 256, BK = 64, HALF = 128, HTB = HALF * BK * 2  , STAGE_BYTES = 8 * HTB, NXCD = 8, WGM = 8;

__host__ __device__ __forceinline__ int lds_byte(int r, int c) { const int st = (r >> 4) * 2 + (c >> 5), rr = r & 15, cc = c & 31, ob = rr * 64 + cc * 2; return st * 1024 + (ob ^ (((ob >> 9) & 1) << 5)); }
__host__ __device__ __forceinline__ void stage_rc(int b, int& R, int& C) { const int st = b / 1024, sb = b % 1024, swz = sb ^ (((sb >> 9) & 1) << 5); R = (st >> 1) * 16 + swz / 64; C = (st & 1) * 32 + (swz % 64) / 2; }
__host__ __device__ __forceinline__ int perm32(int rho) { const int n = rho >> 4, i = rho & 15; return 8 * (i >> 2) + 4 * n + (i & 3); }

struct Unit { int pm, pn, sel; };
struct Gemm { const bf16_t* A; const bf16_t* Bt; int M, N, K; const bf16_t* A2; const bf16_t* Bt2; };

struct StaticOrder {
    int nM, nN, nwg, G, c, wgm;
    __host__ __device__ void init(int M, int N, int G_, int c_, int wgm_ = WGM) { nM = M / BM; nN = N / BM; nwg = nM * nN; G = G_; c = c_; wgm = wgm_; }
    __host__ __device__ bool next(int i, Unit& u) const {
        const long L = (long)i * G + c; if (L >= nwg) return false;
        int wgid = (int)L; { const int q = nwg / NXCD, r = nwg % NXCD, xcd = wgid % NXCD, off = wgid / NXCD; wgid = (xcd < r ? xcd * (q + 1) : r * (q + 1) + (xcd - r) * q) + off; }
        const int nig = wgm * nN, gid = wgid / nig, fm = gid * wgm, gsz = (nM - fm) < wgm ? (nM - fm) : wgm;
        u.pm = fm + ((wgid % nig) % gsz); u.pn = (wgid % nig) / gsz; u.sel = 0; return true;
    }
    __device__ __forceinline__ void a_ready(const Unit&) const {}
    __device__ __forceinline__ void done(const Unit&) const {}
};
struct PairOrder {
    StaticOrder base;
    __host__ __device__ bool next(int i, Unit& u) const { const bool ok = base.next(i >> 1, u); u.sel = i & 1; return ok; }
    __device__ __forceinline__ void a_ready(const Unit&) const {}
    __device__ __forceinline__ void done(const Unit&) const {}
};

__device__ __forceinline__ unsigned cvt_pk_bf16(float lo, float hi) { unsigned r; asm volatile("v_cvt_pk_bf16_f32 %0, %1, %2" : "=v"(r) : "v"(lo), "v"(hi)); return r; }
typedef float f32x2 __attribute__((ext_vector_type(2)));
typedef unsigned u32x2 __attribute__((ext_vector_type(2)));
__device__ __forceinline__ float bf_lo(unsigned w) { return __uint_as_float(w << 16); }
__device__ __forceinline__ float bf_hi(unsigned w) { return __uint_as_float(w & 0xffff0000u); }
__device__ __forceinline__ float sigmoidf_(float v) { return __builtin_amdgcn_rcpf(1.0f + __builtin_amdgcn_exp2f(-1.4426950408889634f * v)); }
__device__ __forceinline__ u32x4 pack8(const f32x4 v0, const f32x4 v1) { u32x4 w; w.x = cvt_pk_bf16(v0[0], v0[1]); w.y = cvt_pk_bf16(v0[2], v0[3]); w.z = cvt_pk_bf16(v1[0], v1[1]); w.w = cvt_pk_bf16(v1[2], v1[3]); return w; }

struct EpiProj {
    static constexpr bool PERM = true, AFTER_DRAIN = false;
    unsigned char* ws; const float* qg; const float* kg; PG8_LAS float* xl;
    __device__ __forceinline__ void operator()(const f32x4 (&acc)[2][2][4][2], const Unit& u, int wr, int wc, int fr, int fq) const {
        const int pn = u.pn;
        int mode, ld, colt, hbase = 0; size_t boff; const float* gain = qg;
        if (pn < 4)        { mode = 1; boff = WS_QA; ld = 1024; colt = pn * 256; hbase = 2 * pn; }
        else if (pn == 4)  { mode = 1; boff = WS_KA; ld = 256;  colt = 0; hbase = 8; gain = kg; }
        else if (pn == 5)  { mode = 0; boff = WS_VA; ld = 256;  colt = 0; }
        else if (pn < 10)  { mode = 2; boff = WS_QB; ld = 1024; colt = (pn - 6) * 256; }
        else if (pn == 10) { mode = 2; boff = WS_KB; ld = 256;  colt = 0; }
        else if (pn == 11) { mode = 0; boff = WS_VB; ld = 256;  colt = 0; }
        else if (pn < 20)  { mode = 3; boff = WS_GA; ld = 2048; colt = (pn - 12) * 256; }
        else               { mode = 3; boff = WS_GB; ld = 2048; colt = (pn - 20) * 256; }
        bf16_t* base = (bf16_t*)(ws + boff);
        const int col0 = colt + wc * 32 + 8 * fq;
        const int row0 = u.pm * BM + wr * 64 + fr;
        if (mode == 0 || mode == 3) {
#pragma unroll
            for (int ai = 0; ai < 2; ++ai)
#pragma unroll
                for (int m = 0; m < 4; ++m) { bf16_t* rowp = base + (size_t)(row0 + ai * HALF + m * 16) * ld + col0;
#pragma unroll
                    for (int bj = 0; bj < 2; ++bj) { f32x4 v0 = acc[ai][bj][m][0], v1 = acc[ai][bj][m][1];
                        if (mode == 3) {
#pragma unroll
                            for (int j = 0; j < 4; ++j) { v0[j] = sigmoidf_(v0[j]); v1[j] = sigmoidf_(v1[j]); } }
                        *(u32x4*)(rowp + bj * HALF) = pack8(v0, v1); } }
        } else if (mode == 2) {
            const float* ct = (const float*)(ws + WS_COST) + wc * 16 + fq * 4; const float* st = (const float*)(ws + WS_SINT) + wc * 16 + fq * 4;
#pragma unroll
            for (int ai = 0; ai < 2; ++ai)
#pragma unroll
                for (int m = 0; m < 4; ++m) { const int tok = row0 + ai * HALF + m * 16; const int t = tok < NPROMPT ? (tok & 8191) : (tok & 2047);
                    const f32x4 c = *(const f32x4*)(ct + t * 64), s = *(const f32x4*)(st + t * 64);
                    bf16_t* rowp = base + (size_t)tok * ld + col0;
#pragma unroll
                    for (int bj = 0; bj < 2; ++bj) { const f32x4 lo = acc[ai][bj][m][0], hi = acc[ai][bj][m][1];
                        *(u32x4*)(rowp + bj * HALF) = pack8(lo * c - hi * s, hi * c + lo * s); } }
        } else {
            const int dlo = 64 * (wc >> 1) + 16 * (wc & 1) + 4 * fq;
            const f32x4 glo = *(const f32x4*)(gain + dlo), ghi = *(const f32x4*)(gain + dlo + 32);
            const float* axt = (const float*)(ws + WS_AX) + ((wc >> 1) ? 8192 : 0);
            const int sinoff = (wc >> 1) ? 2048 : 4096, fi = 16 * (wc & 1) + 4 * fq;
            PG8_LAS float* xq = xl + ((wr * 64 + fr) * 2) * 4 + wc;
#pragma unroll
            for (int ai = 0; ai < 2; ++ai)
#pragma unroll
                for (int m = 0; m < 4; ++m)
#pragma unroll
                    for (int bj = 0; bj < 2; ++bj) { const f32x4 r0 = acc[ai][bj][m][0], r1 = acc[ai][bj][m][1];
                        float q = (r0[0] * r0[0] + r0[1] * r0[1]) + (r0[2] * r0[2] + r0[3] * r0[3]) + (r1[0] * r1[0] + r1[1] * r1[1]) + (r1[2] * r1[2] + r1[3] * r1[3]);
                        q += __shfl_xor(q, 16); q += __shfl_xor(q, 32);
                        if (fq == 0) xq[((ai * HALF + m * 16) * 2 + bj) * 4] = q; }
            asm volatile("s_waitcnt lgkmcnt(0)" ::: "memory"); __builtin_amdgcn_s_barrier(); asm volatile("" ::: "memory");
#pragma unroll
            for (int ai = 0; ai < 2; ++ai)
#pragma unroll
                for (int m = 0; m < 4; ++m) { const int tok = row0 + ai * HALF + m * 16; const int t = tok < NPROMPT ? (tok & 8191) : (tok & 2047);
                    const int pos = (wc >> 1) ? (t & 63) : (t >> 6);
                    const f32x4 c = *(const f32x4*)(axt + pos * 32 + fi), s = *(const f32x4*)(axt + sinoff + pos * 32 + fi);
                    bf16_t* rowp = base + (size_t)tok * ld + col0;
#pragma unroll
                    for (int bj = 0; bj < 2; ++bj) {
                        const f32x4 pp = *(const PG8_LAS f32x4*)(xl + ((wr * 64 + fr + ai * HALF + m * 16) * 2 + bj) * 4);
                        const float rstd = 1.0f / sqrtf(((pp[0] + pp[1]) + (pp[2] + pp[3])) * (1.0f / 128.0f) + RMS_EPS);
                        const f32x4 lo = acc[ai][bj][m][0] * glo * rstd, hi = acc[ai][bj][m][1] * ghi * rstd;
                        *(u32x4*)(rowp + bj * HALF) = pack8(lo * c - hi * s, hi * c + lo * s); } }
        }
    }
};

struct EpiGate2 {
    static constexpr bool PERM = true, AFTER_DRAIN = false;
    const bf16_t* ga; const bf16_t* gb; bf16_t* merged;
    __device__ __forceinline__ void mid(f32x4 (&acc)[2][2][4][2], const Unit& u, int wr, int wc, int fr, int fq) const {
        const int row0 = u.pm * BM + wr * 64 + fr, col0 = u.pn * BM + wc * 32 + 8 * fq;
#pragma unroll
        for (int ai = 0; ai < 2; ++ai)
#pragma unroll
            for (int m = 0; m < 4; ++m) { const size_t off = (size_t)(row0 + ai * HALF + m * 16) * DM + col0;
#pragma unroll
                for (int bj = 0; bj < 2; ++bj) { const u32x4 a = __builtin_nontemporal_load((const u32x4*)(ga + off + bj * HALF)), b = *(const u32x4*)(gb + off + bj * HALF);
                    const f32x4 a0 = {bf_lo(a.x), bf_hi(a.x), bf_lo(a.y), bf_hi(a.y)}, a1 = {bf_lo(a.z), bf_hi(a.z), bf_lo(a.w), bf_hi(a.w)};
                    f32x4 b0 = {bf_lo(b.x), bf_hi(b.x), bf_lo(b.y), bf_hi(b.y)}, b1 = {bf_lo(b.z), bf_hi(b.z), bf_lo(b.w), bf_hi(b.w)};
#pragma unroll
                    for (int j = 0; j < 4; ++j) { b0[j] = __builtin_amdgcn_rcpf(fmaxf(b0[j], 1e-30f)); b1[j] = __builtin_amdgcn_rcpf(fmaxf(b1[j], 1e-30f)); }
                    acc[ai][bj][m][0] = acc[ai][bj][m][0] * (a0 * b0); acc[ai][bj][m][1] = acc[ai][bj][m][1] * (a1 * b1); } }
    }
    __device__ __forceinline__ void operator()(const f32x4 (&acc)[2][2][4][2], const Unit& u, int wr, int wc, int fr, int fq) const {
        const int row0 = u.pm * BM + wr * 64 + fr, col0 = u.pn * BM + wc * 32 + 8 * fq;
#pragma unroll
        for (int ai = 0; ai < 2; ++ai)
#pragma unroll
            for (int m = 0; m < 4; ++m) { const size_t off = (size_t)(row0 + ai * HALF + m * 16) * DM + col0;
#pragma unroll
                for (int bj = 0; bj < 2; ++bj) { const u32x4 b = *(const u32x4*)(gb + off + bj * HALF);
                    f32x4 b0 = {bf_lo(b.x), bf_hi(b.x), bf_lo(b.y), bf_hi(b.y)}, b1 = {bf_lo(b.z), bf_hi(b.z), bf_lo(b.w), bf_hi(b.w)};
#pragma unroll
                    for (int j = 0; j < 4; ++j) { b0[j] = fmaxf(b0[j], 1e-30f); b1[j] = fmaxf(b1[j], 1e-30f); }
                    *(u32x4*)(merged + off + bj * HALF) = pack8(acc[ai][bj][m][0] * b0, acc[ai][bj][m][1] * b1); } }
    }
};
struct EpiF32 {
    static constexpr bool PERM = true, AFTER_DRAIN = false;
    float* O;
    __device__ __forceinline__ void operator()(const f32x4 (&acc)[2][2][4][2], const Unit& u, int wr, int wc, int fr, int fq) const {
        const int row0 = u.pm * BM + wr * 64 + fr, col0 = u.pn * BM + wc * 32 + 8 * fq;
#pragma unroll
        for (int ai = 0; ai < 2; ++ai)
#pragma unroll
            for (int m = 0; m < 4; ++m) { float* rowp = O + (size_t)(row0 + ai * HALF + m * 16) * DM + col0;
#pragma unroll
                for (int bj = 0; bj < 2; ++bj) { *(f32x4*)(rowp + bj * HALF) = acc[ai][bj][m][0]; *(f32x4*)(rowp + bj * HALF + 4) = acc[ai][bj][m][1]; } }
    }
};
struct EpiBf16Plain {
    static constexpr bool PERM = true, AFTER_DRAIN = false;
    bf16_t* O;
    __device__ __forceinline__ void operator()(const f32x4 (&acc)[2][2][4][2], const Unit& u, int wr, int wc, int fr, int fq) const {
        const int row0 = u.pm * BM + wr * 64 + fr, col0 = u.pn * BM + wc * 32 + 8 * fq;
#pragma unroll
        for (int ai = 0; ai < 2; ++ai)
#pragma unroll
            for (int m = 0; m < 4; ++m) { bf16_t* rowp = O + (size_t)(row0 + ai * HALF + m * 16) * DM + col0;
#pragma unroll
                for (int bj = 0; bj < 2; ++bj) *(u32x4*)(rowp + bj * HALF) = pack8(acc[ai][bj][m][0], acc[ai][bj][m][1]); }
    }
};
__device__ __forceinline__ float dpp_shr1(float v) { return __builtin_bit_cast(float, __builtin_amdgcn_update_dpp(0, __builtin_bit_cast(int, v), 0x111, 0xf, 0xf, true)); }
__device__ __forceinline__ float dpp_shl1(float v) { return __builtin_bit_cast(float, __builtin_amdgcn_update_dpp(0, __builtin_bit_cast(int, v), 0x101, 0xf, 0xf, true)); }
__device__ __forceinline__ float dpp_mirror(float v) { return __builtin_bit_cast(float, __builtin_amdgcn_update_dpp(0, __builtin_bit_cast(int, v), 0x140, 0xf, 0xf, true)); }
__device__ __forceinline__ float gelu_tanh_(float a) { const float u2 = a * (1.5957691216f + 0.0713548163f * a * a); return a * __builtin_amdgcn_rcpf(1.0f + __builtin_amdgcn_exp2f(-1.4426950408889634f * u2)); }
__host__ __device__ __forceinline__ int conv_row_token(int P) {
    if (P < 32772) { const int s = P / 8193, r = P - 8193 * s; return r >= 1 ? 8192 * s + r - 1 : -1; }
    if (P < 49165) { const int Q = P - 32772, s2 = Q / 2049, r = Q - 2049 * s2; return r >= 1 ? NPROMPT + 2048 * s2 + r - 1 : -1; }
    return -1;
}
struct EpiConv {
    static constexpr bool PERM = true, AFTER_DRAIN = false;
    const float* cw; const float* cb; bf16_t* act; const int* tokmap;
    __device__ __forceinline__ void operator()(const f32x4 (&acc)[2][2][4][2], const Unit& u, int wr, int wc, int fr, int fq) const {
        PG8_LAS float* const xb = (PG8_LAS float*)131072;
        const int ca0 = u.pn * 128 + wc * 32 + 8 * fq;
        const int cpos = wc * 32 + 8 * fq;
        int tokv[2][4];
        { const int* tm = tokmap + 254 * u.pm + 64 * wr + fr;
#pragma unroll
          for (int ai = 0; ai < 2; ++ai)
#pragma unroll
              for (int m = 0; m < 4; ++m) tokv[ai][m] = tm[128 * ai + 16 * m]; }
#pragma unroll
        for (int ai = 0; ai < 2; ++ai) { const int gi = 2 * ai + wr;
#pragma unroll
            for (int bj = 0; bj < 2; ++bj)
#pragma unroll
                for (int n = 0; n < 2; ++n) {
                    if (fr == 0)  *(PG8_LAS f32x4*)(xb + (gi * 2 + 0) * 256 + 128 * bj + cpos + 4 * n) = acc[ai][bj][0][n];
                    if (fr == 15) *(PG8_LAS f32x4*)(xb + (gi * 2 + 1) * 256 + 128 * bj + cpos + 4 * n) = acc[ai][bj][3][n]; } }
        asm volatile("s_waitcnt lgkmcnt(0)" ::: "memory"); __builtin_amdgcn_s_barrier(); asm volatile("" ::: "memory");
#pragma unroll
        for (int ai = 0; ai < 2; ++ai) {
            const int gi = 2 * ai + wr;
#pragma unroll
            for (int n = 0; n < 2; ++n) {
                const int ca = ca0 + 4 * n;
                f32x4 w0[2], w1[2], w2[2], bb[2];
#pragma unroll
                for (int bj = 0; bj < 2; ++bj) { const int c = ca + bj * DFF; w0[bj] = *(const f32x4*)(cw + c); w1[bj] = *(const f32x4*)(cw + NUP + c); w2[bj] = *(const f32x4*)(cw + 2 * NUP + c); bb[bj] = *(const f32x4*)(cb + c); }
#pragma unroll
                for (int m = 0; m < 4; ++m) {
                    f32x4 cv[2];
#pragma unroll
                    for (int bj = 0; bj < 2; ++bj) {
                        const f32x4 cur = acc[ai][bj][m][n]; f32x4 prv, nxt;
                        f32x4 eprev = {0.f, 0.f, 0.f, 0.f}, enext = {0.f, 0.f, 0.f, 0.f};
                        if (m == 0 && gi > 0) eprev = *(const PG8_LAS f32x4*)(xb + ((gi - 1) * 2 + 1) * 256 + 128 * bj + cpos + 4 * n);
                        if (m == 3 && gi < 3) enext = *(const PG8_LAS f32x4*)(xb + ((gi + 1) * 2 + 0) * 256 + 128 * bj + cpos + 4 * n);
#pragma unroll
                        for (int j = 0; j < 4; ++j) {
                            float p = dpp_shr1(cur[j]), q = dpp_shl1(cur[j]);
                            if (m > 0) { const float e = dpp_mirror(acc[ai][bj][m - 1][n][j]); if (fr == 0) p = e; }
                            else { if (fr == 0) p = eprev[j]; }
                            if (m < 3) { const float e = dpp_mirror(acc[ai][bj][m + 1][n][j]); if (fr == 15) q = e; }
                            else { if (fr == 15) q = enext[j]; }
                            prv[j] = p; nxt[j] = q; }
                        cv[bj] = bb[bj] + w0[bj] * prv + w1[bj] * cur + w2[bj] * nxt;
                    }
                    const int R = 64 * gi + 16 * m + fr;
                    const int tok = tokv[ai][m];
                    if (R >= 1 && R <= 254 && tok >= 0) {
                        u32x2 w; w.x = cvt_pk_bf16(gelu_tanh_(cv[0][0]) * cv[1][0], gelu_tanh_(cv[0][1]) * cv[1][1]); w.y = cvt_pk_bf16(gelu_tanh_(cv[0][2]) * cv[1][2], gelu_tanh_(cv[0][3]) * cv[1][3]);
                        *(u32x2*)(act + (size_t)tok * DFF + ca) = w; }
                }
            }
        }
    }
};

template <class Epi, class Sched, bool ALIGN_EPI = false, bool SP2 = false, bool CONVA = false, bool DUAL = false>
__device__ __forceinline__ void gemm_phase(PG8_LAS unsigned char* lds, const Gemm g, const Sched& S, const Epi& E) {
    int tid_ = threadIdx.x; asm volatile("" : "+v"(tid_));
    const int tid = tid_, wid = __builtin_amdgcn_readfirstlane(tid >> 6), lane = tid & 63, wr = wid >> 2, wc = wid & 3, fr = lane & 15, fq = lane >> 4;
    const int K = g.K, nt = K / BK;
    unsigned voffA[2], voffB[2];
#pragma unroll
    for (int i = 0; i < 2; ++i) { int R, C; stage_rc(tid * 16 + i * 8192, R, C); const int Rb = Epi::PERM ? ((R & ~31) + perm32(R & 31)) : R;
        voffA[i] = (unsigned)(R * K + C) * 2u; voffB[i] = (unsigned)(Rb * K + C) * 2u; }
    const size_t kstep = (size_t)(BK * 2);
    const size_t hstepB = (size_t)HALF * K * 2, hstepA = hstepB;
    const size_t tstepB = 2 * hstepB, tstepA = CONVA ? (size_t)254 * K * 2 : tstepB;
    const unsigned ldsw = (unsigned)wid * 1024u;
    const int aoff = lds_byte(wr * 64 + fr, fq * 8), boff = lds_byte(wc * 32 + fr, fq * 8);
#define PG8_SA(b, h) (((b) * 2 + (h)) * HTB)
#define PG8_SB(b, h) ((4 + (b) * 2 + (h)) * HTB)
#define PG8_STAGE(bufoff, gbase, voff) do { _Pragma("unroll") for (int _i = 0; _i < 2; ++_i) \
        __builtin_amdgcn_global_load_lds((const unsigned*)((const char*)(gbase) + (voff)[_i]), (PG8_LAS unsigned*)(lds + (bufoff) + ldsw + _i * 8192), 16, 0, 0); } while (0)
#define PG8_LDA(dst, b, h) do { _Pragma("unroll") for (int m = 0; m < 4; ++m) _Pragma("unroll") for (int k = 0; k < 2; ++k) dst[m][k] = *(const PG8_LAS bf16x8*)(lds + PG8_SA(b, h) + aoff + m * 2048 + k * 1024); } while (0)
#define PG8_LDB(dst, b, h) do { _Pragma("unroll") for (int n = 0; n < 2; ++n) _Pragma("unroll") for (int k = 0; k < 2; ++k) dst[n][k] = *(const PG8_LAS bf16x8*)(lds + PG8_SB(b, h) + boff + n * 2048 + k * 1024); } while (0)
#define PG8_MMA(ai, bj, At, Bt) do { __builtin_amdgcn_s_setprio(1); _Pragma("unroll") for (int m = 0; m < 4; ++m) _Pragma("unroll") for (int n = 0; n < 2; ++n) _Pragma("unroll") for (int k = 0; k < 2; ++k) \
        acc[ai][bj][m][n] = __builtin_amdgcn_mfma_f32_16x16x32_bf16(Bt[n][k], At[m][k], acc[ai][bj][m][n], 0, 0, 0); __builtin_amdgcn_s_setprio(0); } while (0)
#define PG8_WAIT_V(n) asm volatile("s_waitcnt vmcnt(" #n ")" ::: "memory")
#define PG8_WAIT_L(n) asm volatile("s_waitcnt lgkmcnt(" #n ")" ::: "memory")
#define PG8_BAR __builtin_amdgcn_s_barrier()
#define PG8_SCHED __builtin_amdgcn_sched_barrier(0)
    Unit cur, nxt; int ui = 0;
    if (!S.next(0, cur)) return;
    f32x4 acc[2][2][4][2];
#pragma unroll
    for (int a = 0; a < 2; ++a)
#pragma unroll
        for (int b = 0; b < 2; ++b)
#pragma unroll
            for (int m = 0; m < 4; ++m)
#pragma unroll
                for (int n = 0; n < 2; ++n) acc[a][b][m][n] = (f32x4){0.f, 0.f, 0.f, 0.f};
    bf16x8 At[4][2], B0[2][2], B1[2][2];
    const char* cA = (const char*)((DUAL && cur.sel) ? g.A2 : g.A) + (size_t)cur.pm * tstepA; const char* cB = (const char*)((DUAL && cur.sel) ? g.Bt2 : g.Bt) + (size_t)cur.pn * tstepB;
    S.a_ready(cur);
    if constexpr (SP2) {
        PG8_STAGE(PG8_SB(0, 0), cB, voffB); PG8_STAGE(PG8_SB(0, 1), cB + hstepB, voffB); PG8_STAGE(PG8_SA(0, 0), cA, voffA); PG8_STAGE(PG8_SA(0, 1), cA + hstepA, voffA);
        if (wr == 1) PG8_BAR;
        PG8_WAIT_V(2); PG8_BAR;
        PG8_STAGE(PG8_SB(1, 0), cB + kstep, voffB); PG8_STAGE(PG8_SA(1, 0), cA + kstep, voffA); PG8_STAGE(PG8_SB(1, 1), cB + hstepB + kstep, voffB);
        PG8_WAIT_V(6); PG8_BAR;
    } else {
        PG8_STAGE(PG8_SB(0, 0), cB, voffB); PG8_STAGE(PG8_SA(0, 0), cA, voffA); PG8_STAGE(PG8_SB(0, 1), cB + hstepB, voffB); PG8_STAGE(PG8_SA(0, 1), cA + hstepA, voffA);
        if (wr == 1) PG8_BAR;
        PG8_WAIT_V(4); PG8_BAR;
        PG8_STAGE(PG8_SB(1, 0), cB + kstep, voffB); PG8_STAGE(PG8_SA(1, 0), cA + kstep, voffA); PG8_STAGE(PG8_SB(1, 1), cB + hstepB + kstep, voffB);
        PG8_WAIT_V(6); PG8_BAR;
    }
    for (;;) {
        const bool has_next = S.next(ui + 1, nxt);
        const char* nA = has_next ? (const char*)((DUAL && nxt.sel) ? g.A2 : g.A) + (size_t)nxt.pm * tstepA : cA; const char* nB = has_next ? (const char*)((DUAL && nxt.sel) ? g.Bt2 : g.Bt) + (size_t)nxt.pn * tstepB : cB;
        for (int t = 0; t < nt; t += 2) {
            const bool last = (t == nt - 2);
            const char* a1 = cA + (size_t)(t + 1) * kstep;
            const char* a2 = last ? nA : cA + (size_t)(t + 2) * kstep; const char* b2 = last ? nB : cB + (size_t)(t + 2) * kstep;
            const char* a3 = a2 + kstep; const char* b3 = b2 + kstep;
            if (last && has_next) S.a_ready(nxt);
            if constexpr (SP2) {
            PG8_LDB(B0, 0, 0); PG8_LDB(B1, 0, 1); PG8_SCHED; PG8_LDA(At, 0, 0); PG8_STAGE(PG8_SA(1, 1), a1 + hstepA, voffA);
            PG8_WAIT_V(8); PG8_WAIT_L(0); PG8_BAR; PG8_MMA(0, 0, At, B0); PG8_MMA(0, 1, At, B1); PG8_BAR; PG8_SCHED;
            PG8_LDA(At, 0, 1); PG8_STAGE(PG8_SB(0, 0), b2, voffB); PG8_STAGE(PG8_SB(0, 1), b2 + hstepB, voffB); PG8_STAGE(PG8_SA(0, 0), a2, voffA);
            PG8_WAIT_V(8); PG8_WAIT_L(0); PG8_BAR; PG8_MMA(1, 0, At, B0); PG8_MMA(1, 1, At, B1); PG8_BAR; PG8_SCHED;
            PG8_LDB(B0, 1, 0); PG8_LDB(B1, 1, 1); PG8_SCHED; PG8_LDA(At, 1, 0); PG8_STAGE(PG8_SA(0, 1), a2 + hstepA, voffA);
            PG8_WAIT_V(8); PG8_WAIT_L(0); PG8_BAR; PG8_MMA(0, 0, At, B0); PG8_MMA(0, 1, At, B1); PG8_BAR; PG8_SCHED;
            PG8_LDA(At, 1, 1); PG8_STAGE(PG8_SB(1, 0), b3, voffB); PG8_STAGE(PG8_SB(1, 1), b3 + hstepB, voffB); PG8_STAGE(PG8_SA(1, 0), a3, voffA);
            PG8_WAIT_V(8); PG8_WAIT_L(0); PG8_BAR; PG8_MMA(1, 0, At, B0); PG8_MMA(1, 1, At, B1); PG8_BAR; PG8_SCHED;
            } else {
            PG8_LDB(B0, 0, 0); PG8_SCHED; PG8_LDA(At, 0, 0); PG8_STAGE(PG8_SA(1, 1), a1 + hstepA, voffA);
            PG8_WAIT_L(8); PG8_BAR; PG8_WAIT_L(0); PG8_MMA(0, 0, At, B0); PG8_BAR; PG8_SCHED;
            PG8_LDB(B1, 0, 1); PG8_STAGE(PG8_SB(0, 0), b2, voffB);
            PG8_BAR; PG8_WAIT_L(0); PG8_MMA(0, 1, At, B1); PG8_BAR;
            PG8_LDA(At, 0, 1); PG8_STAGE(PG8_SA(0, 0), a2, voffA);
            PG8_BAR; PG8_WAIT_L(0); PG8_MMA(1, 0, At, B0); PG8_BAR; PG8_SCHED;
            PG8_STAGE(PG8_SB(0, 1), b2 + hstepB, voffB);
            PG8_WAIT_V(6); PG8_BAR; PG8_MMA(1, 1, At, B1); PG8_BAR;
            PG8_LDB(B0, 1, 0); PG8_SCHED; PG8_LDA(At, 1, 0); PG8_STAGE(PG8_SA(0, 1), a2 + hstepA, voffA);
            PG8_WAIT_L(8); PG8_BAR; PG8_WAIT_L(0); PG8_MMA(0, 0, At, B0); PG8_BAR; PG8_SCHED;
            PG8_LDB(B1, 1, 1); PG8_STAGE(PG8_SB(1, 0), b3, voffB);
            PG8_BAR; PG8_WAIT_L(0); PG8_MMA(0, 1, At, B1); PG8_BAR;
            PG8_LDA(At, 1, 1); PG8_STAGE(PG8_SA(1, 0), a3, voffA);
            PG8_BAR; PG8_WAIT_L(0); PG8_MMA(1, 0, At, B0); PG8_BAR; PG8_SCHED;
            PG8_STAGE(PG8_SB(1, 1), b3 + hstepB, voffB);
            PG8_WAIT_V(6); PG8_BAR; PG8_MMA(1, 1, At, B1); PG8_BAR;
            }
        }
        if constexpr (ALIGN_EPI) { if (wr == 0) PG8_BAR; }
        if constexpr (DUAL) { if (cur.sel == 0) E.mid(acc, cur, wr, wc, fr, fq); else E(acc, cur, wr, wc, fr, fq); }
        else if constexpr (!Epi::AFTER_DRAIN) { E(acc, cur, wr, wc, fr, fq); S.done(cur); }
        if (!has_next) break;
        if (!(DUAL && cur.sel == 0)) {
#pragma unroll
        for (int a = 0; a < 2; ++a)
#pragma unroll
            for (int b = 0; b < 2; ++b)
#pragma unroll
                for (int m = 0; m < 4; ++m)
#pragma unroll
                    for (int n = 0; n < 2; ++n) acc[a][b][m][n] = (f32x4){0.f, 0.f, 0.f, 0.f};
        }
        cur = nxt; cA = nA; cB = nB; ++ui;
        if constexpr (ALIGN_EPI) { if (wr == 1) PG8_BAR; }
    }
    PG8_WAIT_V(0);
    if constexpr (!ALIGN_EPI) { if (wr == 0) PG8_BAR; }
    PG8_BAR;
    if constexpr (Epi::AFTER_DRAIN) { E.fused(acc, cur, wr, wc, fr, fq, lds, wid, lane); S.done(cur); }
#undef PG8_SA
#undef PG8_SB
#undef PG8_STAGE
#undef PG8_LDA
#undef PG8_LDB
#undef PG8_MMA
#undef PG8_WAIT_V
#undef PG8_WAIT_L
#undef PG8_BAR
#undef PG8_SCHED
}
}
namespace att {
using bf16 = __hip_bfloat16;
constexpr int D = 128, NW = 8, QBLK = 32, KVBLK = 64;
constexpr float SCALE = 0.088388347648318440f;
constexpr float THR = 8.f;
constexpr int LDQ = 1024, LDK = 256, LDO = 1024;
constexpr size_t SHM_V = KVBLK * D * 2, SHM_K = KVBLK * D * 2, SHM_ATTN = 3 * SHM_V + 2 * SHM_K + NW * 64 * 4;
using bf16x8 = __attribute__((ext_vector_type(8))) short;
using s16x4  = __attribute__((ext_vector_type(4))) short;
using f32x16 = __attribute__((ext_vector_type(16))) float;
using u32x4  = __attribute__((ext_vector_type(4))) unsigned;
#define KSWZ(row, colB) ((row) * 256 + ((colB) ^ (((row) & 7) << 4)))
#define SBAR() __builtin_amdgcn_sched_barrier(0)
__device__ __forceinline__ int crow(int r, int hi) { return (r & 3) + 8 * (r >> 2) + 4 * hi; }
__device__ __forceinline__ unsigned cvtpk(float lo, float hi) { unsigned r; asm volatile("v_cvt_pk_bf16_f32 %0, %1, %2" : "=v"(r) : "v"(lo), "v"(hi)); return r; }
template <bool WIN>
__device__ __forceinline__ void partialSM(f32x16& p0, f32x16& p1, float& m_reg, float& mn, float& alpha, int mb) {
  constexpr float C = SCALE * 1.4426950408889634f;
  if (WIN) {
#pragma unroll
    for (int r = 0; r < 16; ++r) { const int d0 = mb + (r & 3) + 8 * (r >> 2);
      if ((unsigned)(d0 + 128) > 256u) p0[r] = -1e30f;
      if ((unsigned)(d0 + 160) > 256u) p1[r] = -1e30f; }
  }
  float pmax = p0[0]; for (int r = 1; r < 16; ++r) pmax = fmaxf(pmax, p0[r]); for (int r = 0; r < 16; ++r) pmax = fmaxf(pmax, p1[r]);
  { auto rr = __builtin_amdgcn_permlane32_swap(__float_as_uint(pmax), __float_as_uint(pmax), false, false);
    pmax = fmaxf(__uint_as_float(rr[0]), __uint_as_float(rr[1])); }
  if (__builtin_expect(__all(pmax - m_reg <= THR / SCALE), 1)) { mn = m_reg; alpha = 1.f; }
  else { mn = fmaxf(m_reg, pmax); alpha = __builtin_amdgcn_exp2f((m_reg - mn) * C); m_reg = mn; }
  float mnC = -mn * C;
  for (int r = 0; r < 16; ++r) p0[r] = fmaf(p0[r], C, mnC); for (int r = 0; r < 16; ++r) p1[r] = fmaf(p1[r], C, mnC);
  for (int r = 0; r < 16; ++r) p0[r] = __builtin_amdgcn_exp2f(p0[r]);
}
__device__ __forceinline__ void finishSM(f32x16& p0, f32x16& p1, float alpha, float& l_reg, bf16x8& pa0, bf16x8& pa1, bf16x8& pa2, bf16x8& pa3) {
  for (int r = 0; r < 16; ++r) p1[r] = __builtin_amdgcn_exp2f(p1[r]);
  float ps = 0; for (int r = 0; r < 16; ++r) ps += p0[r]; for (int r = 0; r < 16; ++r) ps += p1[r];
  { auto rr = __builtin_amdgcn_permlane32_swap(__float_as_uint(ps), __float_as_uint(ps), false, false);
    ps = __uint_as_float(rr[0]) + __uint_as_float(rr[1]); }
  l_reg = l_reg * alpha + ps;
#define PK4(P, BASE, OUT) do { unsigned a0 = cvtpk(P[BASE + 0], P[BASE + 1]), a1 = cvtpk(P[BASE + 2], P[BASE + 3]);   \
    unsigned b0 = cvtpk(P[BASE + 4], P[BASE + 5]), b1 = cvtpk(P[BASE + 6], P[BASE + 7]);                              \
    auto r0 = __builtin_amdgcn_permlane32_swap(a0, b0, false, false); auto r1 = __builtin_amdgcn_permlane32_swap(a1, b1, false, false); \
    u32x4 w = {r0[0], r1[0], r0[1], r1[1]}; OUT = *reinterpret_cast<bf16x8*>(&w); } while (0)
  PK4(p0, 0, pa0); PK4(p0, 8, pa1); PK4(p1, 0, pa2); PK4(p1, 8, pa3);
#undef PK4
}
__device__ __forceinline__ void qkt(f32x16& p0, f32x16& p1, const bf16* Ks, const bf16x8* qr, int r32, int hi) {
  p0 = f32x16{}; p1 = f32x16{};
  for (int d0 = 0; d0 < 8; ++d0) { int cb = (d0 * 16 + hi * 8) * 2;
    bf16x8 b0 = *reinterpret_cast<const bf16x8*>((const char*)Ks + KSWZ(r32, cb));
    bf16x8 b1 = *reinterpret_cast<const bf16x8*>((const char*)Ks + KSWZ(32 + r32, cb));
    p0 = __builtin_amdgcn_mfma_f32_32x32x16_bf16(b0, qr[d0], p0, 0, 0, 0);
    p1 = __builtin_amdgcn_mfma_f32_32x32x16_bf16(b1, qr[d0], p1, 0, 0, 0); }
}
__device__ __forceinline__ int v_st(int k, int c) { const int kk = (k & ~0xC) | ((k & 4) << 1) | ((k & 8) >> 1); return ((kk >> 3) * 4 + (c >> 5)) * 512 + ((kk & 7) * 32 + (c & 31)) * 2; }
__device__ __forceinline__ int v_rd_base(int lane) { return ((lane & 3) << 3) | (((lane >> 2) & 3) << 6) | (((lane >> 4) & 1) << 5) | (((lane >> 5) & 1) << 8); }
constexpr int v_rd_off(int d0, int ks, int half) { return d0 * 512 + ks * 4096 + half * 2048; }
template <int OFF> __device__ __forceinline__ s16x4 tr_read(int vb) {
  s16x4 r; asm volatile("ds_read_b64_tr_b16 %0, %1 offset:%2" : "=&v"(r) : "v"(vb), "i"(OFF) : "memory"); return r;
}
template <int D0> __device__ __forceinline__ void pv_one(f32x16& od, int vb, bf16x8 pa0, bf16x8 pa1, bf16x8 pa2, bf16x8 pa3) {
  const s16x4 l0 = tr_read<v_rd_off(D0, 0, 0)>(vb), h0 = tr_read<v_rd_off(D0, 0, 1)>(vb), l1 = tr_read<v_rd_off(D0, 1, 0)>(vb), h1 = tr_read<v_rd_off(D0, 1, 1)>(vb);
  const s16x4 l2 = tr_read<v_rd_off(D0, 2, 0)>(vb), h2 = tr_read<v_rd_off(D0, 2, 1)>(vb), l3 = tr_read<v_rd_off(D0, 3, 0)>(vb), h3 = tr_read<v_rd_off(D0, 3, 1)>(vb);
  asm volatile("s_waitcnt lgkmcnt(0)" ::: "memory"); SBAR();
#define PK(L, H) (bf16x8){L[0], L[1], L[2], L[3], H[0], H[1], H[2], H[3]}
  od = __builtin_amdgcn_mfma_f32_32x32x16_bf16(pa0, PK(l0, h0), od, 0, 0, 0);
  od = __builtin_amdgcn_mfma_f32_32x32x16_bf16(pa1, PK(l1, h1), od, 0, 0, 0);
  od = __builtin_amdgcn_mfma_f32_32x32x16_bf16(pa2, PK(l2, h2), od, 0, 0, 0);
  od = __builtin_amdgcn_mfma_f32_32x32x16_bf16(pa3, PK(l3, h3), od, 0, 0, 0);
#undef PK
}
__device__ __forceinline__ void pv_d0(f32x16* o, int vb, bf16x8 pa0, bf16x8 pa1, bf16x8 pa2, bf16x8 pa3) {
  pv_one<0>(o[0], vb, pa0, pa1, pa2, pa3); pv_one<1>(o[1], vb, pa0, pa1, pa2, pa3); pv_one<2>(o[2], vb, pa0, pa1, pa2, pa3); pv_one<3>(o[3], vb, pa0, pa1, pa2, pa3);
}
template <bool WIN, int SDEPTH>
__device__ __forceinline__ void attn_unit(const bf16* __restrict__ Qb, const bf16* __restrict__ Kh, const bf16* __restrict__ Vh, bf16* __restrict__ Ob, int NT, char* lds, int dk0, float sink) {
  int tid_ = threadIdx.x; asm volatile("" : "+v"(tid_));
  const int tid = tid_, wid = tid >> 6, lane = tid & 63, r32 = lane & 31, hi = lane >> 5;
  bf16* V_lds = (bf16*)lds; bf16* K_lds = (bf16*)(lds + 3 * SHM_V);
  float* ws = (float*)(lds + 3 * SHM_V + 2 * SHM_K) + wid * 64; float* li_l = ws; float* al_l = ws + 32;
  float m_reg = WIN ? sink * (1.0f / SCALE) : -1e30f, l_reg = WIN ? 1.f : 0.f; f32x16 o[4] = {}; bf16x8 qr[8];
  const int mb0 = dk0 + 4 * hi - (wid * QBLK + r32);
  const bf16* Qw = Qb + (long)(wid * QBLK + r32) * LDQ + hi * 8;
#pragma unroll
  for (int d0 = 0; d0 < 8; ++d0) qr[d0] = *reinterpret_cast<const bf16x8*>(Qw + d0 * 16);
  const int sr = tid >> 4, sc = (tid & 15) * 8, vst0 = v_st(sr, sc), vst1 = v_st(32 + sr, sc);
  const int vb0 = (int)(uintptr_t)V_lds + v_rd_base(lane);
  struct { bf16x8 vs0, vs1, ks0, ks1; } sr_[SDEPTH];
#define SLOAD(i, k0) do { sr_[i].vs0 = *reinterpret_cast<const bf16x8*>(&Vh[(long)((k0) + sr) * LDK + sc]); sr_[i].vs1 = *reinterpret_cast<const bf16x8*>(&Vh[(long)((k0) + 32 + sr) * LDK + sc]); \
    sr_[i].ks0 = *reinterpret_cast<const bf16x8*>(&Kh[(long)((k0) + sr) * LDK + sc]); sr_[i].ks1 = *reinterpret_cast<const bf16x8*>(&Kh[(long)((k0) + 32 + sr) * LDK + sc]); } while (0)
#define SWRITE2(b, i, vs) do { *(bf16x8*)((char*)V_lds + (vs) * SHM_V + vst0) = sr_[i].vs0;          \
    *(bf16x8*)((char*)V_lds + (vs) * SHM_V + vst1) = sr_[i].vs1; int kc = sc * 2;               \
    *(bf16x8*)((char*)K_lds + (b) * SHM_K + KSWZ(sr, kc)) = sr_[i].ks0;                       \
    *(bf16x8*)((char*)K_lds + (b) * SHM_K + KSWZ(32 + sr, kc)) = sr_[i].ks1; } while (0)
#define SWRITE(b, i) SWRITE2(b, i, b)
#define SWAIT() do { if constexpr (SDEPTH == 2) asm volatile("s_waitcnt vmcnt(4)" ::: "memory"); else asm volatile("s_waitcnt vmcnt(0)" ::: "memory"); } while (0)
#define RESC(a) do { if (__any((a) < 1.f)) { if (hi == 0) al_l[r32] = (a); asm volatile("s_waitcnt lgkmcnt(0)" ::: "memory"); \
    for (int d = 0; d < 4; ++d) for (int r = 0; r < 16; ++r) o[d][r] *= al_l[crow(r, hi)]; } } while (0)
  f32x16 pA0, pA1, pB0, pB1; float mnA, mnB, alA, alB; bf16x8 pa0, pa1, pa2, pa3;
  const int wq = __builtin_amdgcn_readfirstlane(wid) * QBLK;
#define NEED(j) (!WIN || ((64 * (j) + dk0 + 63 >= wq - 128) && (64 * (j) + dk0 <= wq + QBLK - 1 + 128)))
#define QKT(P0, P1, Ks, j) do { if (NEED(j)) qkt(P0, P1, Ks, qr, r32, hi); else { _Pragma("unroll") for (int r_ = 0; r_ < 16; ++r_) { P0[r_] = -1e30f; P1[r_] = -1e30f; } } } while (0)
#define PV(vb, j) do { if (NEED(j)) pv_d0(o, vb, pa0, pa1, pa2, pa3); } while (0)
  constexpr int SE = 0, SO = SDEPTH - 1;
  SLOAD(SE, 0); asm volatile("s_waitcnt vmcnt(0)" ::: "memory"); SWRITE(0, SE); __syncthreads();
  QKT(pA0, pA1, K_lds, 0); partialSM<WIN>(pA0, pA1, m_reg, mnA, alA, mb0);
  SLOAD(SO, KVBLK); if constexpr (SDEPTH == 2) { if (2 < NT) SLOAD(SE, 2 * KVBLK); }
  SWAIT(); SWRITE(1, SO); __syncthreads();
#define HSTEP(PN0, PN1, MNN, ALN, PO0, PO1, ALO, KB, VRD, VWR, t) do { \
    SBAR(); QKT(PN0, PN1, (bf16*)((char*)K_lds + (KB) * SHM_K), t); \
    finishSM(PO0, PO1, ALO, l_reg, pa0, pa1, pa2, pa3); SBAR(); \
    SLOAD(SE, ((t) + 1) * KVBLK); SBAR(); \
    PV(vb0 + (VRD) * (int)SHM_V, (t) - 1); partialSM<WIN>(PN0, PN1, m_reg, MNN, ALN, mb0 + 64 * (t)); \
    SWAIT(); SWRITE2((KB) ^ 1, SE, VWR); \
    RESC(ALN); __syncthreads(); } while (0)
  if constexpr (!WIN && SDEPTH == 1) {
    for (int j = 1; j + 1 < NT; j += 6) {
      HSTEP(pB0, pB1, mnB, alB, pA0, pA1, alA, 1, 0, 2, j);
      HSTEP(pA0, pA1, mnA, alA, pB0, pB1, alB, 0, 1, 0, j + 1);
      HSTEP(pB0, pB1, mnB, alB, pA0, pA1, alA, 1, 2, 1, j + 2);
      HSTEP(pA0, pA1, mnA, alA, pB0, pB1, alB, 0, 0, 2, j + 3);
      HSTEP(pB0, pB1, mnB, alB, pA0, pA1, alA, 1, 1, 0, j + 4);
      HSTEP(pA0, pA1, mnA, alA, pB0, pB1, alB, 0, 2, 1, j + 5);
    }
    SBAR(); QKT(pB0, pB1, (bf16*)((char*)K_lds + SHM_K), NT - 1);
    finishSM(pA0, pA1, alA, l_reg, pa0, pa1, pa2, pa3); SBAR();
    PV(vb0, NT - 2); partialSM<WIN>(pB0, pB1, m_reg, mnB, alB, mb0 + 64 * (NT - 1));
    RESC(alB);
    finishSM(pB0, pB1, alB, l_reg, pa0, pa1, pa2, pa3); SBAR();
    PV(vb0 + (int)SHM_V, NT - 1);
  } else {
  for (int j = 1; j + 1 < NT; j += 2) {
    SBAR(); QKT(pB0, pB1, (bf16*)((char*)K_lds + SHM_K), j);
    finishSM(pA0, pA1, alA, l_reg, pa0, pa1, pa2, pa3); SBAR();
    SLOAD(SO, (j + SDEPTH) * KVBLK); SBAR();
    PV(vb0, j - 1); partialSM<WIN>(pB0, pB1, m_reg, mnB, alB, mb0 + 64 * j);
    __syncthreads(); SWAIT(); SWRITE(0, SE);
    RESC(alB); __syncthreads();
    SBAR(); QKT(pA0, pA1, K_lds, j + 1);
    finishSM(pB0, pB1, alB, l_reg, pa0, pa1, pa2, pa3); SBAR();
    if (SDEPTH == 1 || j + 3 < NT) SLOAD(SE, (j + 1 + SDEPTH) * KVBLK); SBAR();
    PV(vb0 + (int)SHM_V, j); partialSM<WIN>(pA0, pA1, m_reg, mnA, alA, mb0 + 64 * (j + 1));
    __syncthreads(); SWAIT(); SWRITE(1, SO);
    RESC(alA); __syncthreads();
  }
  SBAR(); QKT(pB0, pB1, (bf16*)((char*)K_lds + SHM_K), NT - 1);
  finishSM(pA0, pA1, alA, l_reg, pa0, pa1, pa2, pa3); SBAR();
  PV(vb0, NT - 2); partialSM<WIN>(pB0, pB1, m_reg, mnB, alB, mb0 + 64 * (NT - 1));
  __syncthreads(); RESC(alB);
  finishSM(pB0, pB1, alB, l_reg, pa0, pa1, pa2, pa3); SBAR();
  PV(vb0 + (int)SHM_V, NT - 1);
  }
  if (hi == 0) li_l[r32] = l_reg; asm volatile("s_waitcnt lgkmcnt(0)" ::: "memory");
  float rli[16];
#pragma unroll
  for (int r = 0; r < 16; ++r) rli[r] = __builtin_amdgcn_rcpf(li_l[crow(r, hi)]);
  bf16* Ow = Ob + (long)(wid * QBLK) * LDO;
#pragma unroll
  for (int r = 0; r < 16; ++r) { int orow = crow(r, hi);
    for (int d0 = 0; d0 < 4; ++d0) Ow[(long)orow * LDO + d0 * 32 + r32] = __float2bfloat16(o[d0][r] * rli[r]); }
  asm volatile("s_waitcnt lgkmcnt(0)" ::: "memory"); __syncthreads();
#undef HSTEP
#undef SWRITE2
#undef NEED
#undef QKT
#undef PV
#undef SLOAD
#undef SWRITE
#undef SWAIT
#undef RESC
}
#undef KSWZ
#undef SBAR
}

#ifndef SD_DENSE
#define SD_DENSE 2
#endif
#ifndef SD_WIN
#define SD_WIN 1
#endif
#ifndef WGM_P1
#define WGM_P1 4
#endif
#ifndef WGM_P3
#define WGM_P3 4
#endif
#ifndef WGM_P3C
#define WGM_P3C 4
#endif
#ifndef WGM_P4
#define WGM_P4 4
#endif
#ifndef WGM_P5
#define WGM_P5 4
#endif
#ifndef ROWS_P0
#define ROWS_P0 2
#endif
#ifndef ROWS_P6
#define ROWS_P6 2
#endif
#ifndef REP_PHASE
#define REP_PHASE -1
#endif
#define LAS __attribute__((address_space(3)))
typedef unsigned short bf16r;
typedef unsigned v4u __attribute__((ext_vector_type(4)));
typedef unsigned v2u __attribute__((ext_vector_type(2)));
typedef float v4f __attribute__((ext_vector_type(4)));
constexpr int NWAVES = 8;
__device__ __forceinline__ unsigned f2bf(float f) { unsigned u = __builtin_bit_cast(unsigned, f); return (u + 0x7fffu + ((u >> 16) & 1u)) >> 16; }
__device__ __forceinline__ unsigned pk2(float lo, float hi) { return f2bf(lo) | (f2bf(hi) << 16); }
__device__ __forceinline__ float wave_sum(float v) {
#pragma unroll
    for (int o = 1; o < 64; o <<= 1) v += __shfl_xor(v, o);
    return v;
}
__device__ __forceinline__ int map_win(int c) {
    if (c < 1280) { const int d = c & 127; const int p = 32 * (2 * (d >> 6) + ((d >> 4) & 1)) + 8 * ((d >> 2) & 3) + 4 * ((d >> 5) & 1) + (d & 3); return (c & ~127) + p; }
    if (c >= 1536 && c < 2816) { const int d = c & 127; const int p = 32 * ((d >> 4) & 3) + 8 * ((d >> 2) & 3) + 4 * (d >> 6) + (d & 3); return (c & ~127) + p; }
    return c;
}
__device__ __forceinline__ int map_wup(int c) { return c < DFF ? ((c >> 7) * 256 + (c & 127)) : (((c - DFF) >> 7) * 256 + 128 + ((c - DFF) & 127)); }
template <int MAP>
__device__ __forceinline__ void transpose_item(const float* W, int K, int N, bf16r* WT, LAS float* scr, int item, int lane) {
    const int nblk = N / 32, kb = item / nblk, nb = item % nblk, k0 = 64 * kb, n0 = 32 * nb;
#pragma unroll 8
    for (int i = 0; i < 32; ++i) { const int kk = 2 * i + (lane >> 5); scr[kk * 33 + (lane & 31)] = __builtin_nontemporal_load(W + (size_t)(k0 + kk) * N + n0 + (lane & 31)); }
    asm volatile("s_waitcnt lgkmcnt(0)" ::: "memory");
    const int c = lane & 7;
#pragma unroll
    for (int j = 0; j < 4; ++j) { const int n = (lane >> 3) + 8 * j; const LAS float* s = scr + (8 * c) * 33 + n;
        v4u o; o.x = pk2(s[0 * 33], s[1 * 33]); o.y = pk2(s[2 * 33], s[3 * 33]); o.z = pk2(s[4 * 33], s[5 * 33]); o.w = pk2(s[6 * 33], s[7 * 33]);
        const int src = n0 + n; const int dst = MAP == 1 ? map_win(src) : (MAP == 2 ? map_wup(src) : src);
        *(v4u*)(WT + (size_t)dst * K + k0 + 8 * c) = o; }
    asm volatile("s_waitcnt lgkmcnt(0)" ::: "memory");
}
__device__ __forceinline__ const float* xrow_ptr(const float* xp, const float* xs, int tok) { return tok < NPROMPT ? xp + (size_t)tok * DM : xs + (size_t)(tok - NPROMPT) * DM; }

#define XB_TMO      128
#define XB_XCNT(j)  (256  + 64 * (j))
#define XB_XSUB(j)  (1280 + 64 * (j))
#define XB_XGEN(j)  (2304 + 64 * (j))
#define XB_TOP      3328
#define XB_TOPGEN   3392
#define XCD_BAR_WORDS 3456
#define XB_SPIN_CAP (1u << 22)

__device__ __forceinline__ unsigned xb_ld(unsigned* p)              { return __hip_atomic_load(p, __ATOMIC_RELAXED, __HIP_MEMORY_SCOPE_AGENT); }
__device__ __forceinline__ unsigned xb_add(unsigned* p, unsigned v) { return __hip_atomic_fetch_add(p, v, __ATOMIC_RELAXED, __HIP_MEMORY_SCOPE_AGENT); }
__device__ __forceinline__ unsigned xb_xcc_id() { return (unsigned)__builtin_amdgcn_s_getreg((3 << 11) | 20) & 0xFu; }
#define XB_SPIN(cond, bar) do { unsigned _sp = 0; while (cond) { __builtin_amdgcn_s_sleep(1); \
    if ((++_sp & 255u) == 0u) { if (xb_ld(&(bar)[XB_TMO])) break; if (_sp > XB_SPIN_CAP) { atomicAdd(&(bar)[XB_TMO], 1u); break; } } } } while (0)

struct XcdBarrier {
    unsigned* bar; unsigned x;
    volatile LAS unsigned* st;
};

__device__ __forceinline__ XcdBarrier xcd_barrier_post(unsigned* bar, volatile LAS unsigned* st) {
    XcdBarrier b; b.bar = bar; b.x = xb_xcc_id(); b.st = st;
    if (threadIdx.x == 0) (void)xb_add(&bar[XB_XCNT(b.x)], 1u);
    return b;
}
__device__ __forceinline__ void xcd_barrier_complete(unsigned* bar, unsigned x, unsigned& nloc, unsigned& nx) {
    const unsigned G = gridDim.x * gridDim.y * gridDim.z;
    unsigned sum, cnt, mine, sp = 0u;
    for (;;) {
        sum = 0u; cnt = 0u; mine = 0u;
#pragma unroll
        for (unsigned j = 0; j < 16; ++j) { const unsigned c = xb_ld(&bar[XB_XCNT(j)]); sum += c; cnt += (c > 0u) ? 1u : 0u; mine = (j == x) ? c : mine; }
        if (sum == G) break;
        __builtin_amdgcn_s_sleep(1);
        if ((++sp & 255u) == 0u) { if (xb_ld(&bar[XB_TMO])) break; if (sp > XB_SPIN_CAP) { atomicAdd(&bar[XB_TMO], 1u); break; } }
    }
    nloc = mine > 0u ? mine : 1u; nx = cnt > 0u ? cnt : 1u;
}

__device__ __forceinline__ void xcd_barrier(const XcdBarrier& b) {
    asm volatile("s_waitcnt vmcnt(0)" ::: "memory");
    __syncthreads();
    if (threadIdx.x == 0) {
        unsigned* bar = b.bar;
        __builtin_amdgcn_s_waitcnt(0);
        unsigned nloc = b.st[0], nx = b.st[1];
        if (nloc == 0u) { xcd_barrier_complete(bar, b.x, nloc, nx); b.st[0] = nloc; b.st[1] = nx; }
        const unsigned old = xb_add(&bar[XB_XSUB(b.x)], 1u);
        const unsigned gen = old / nloc;
        if (old + 1u == (gen + 1u) * nloc) {
            __builtin_amdgcn_fence(__ATOMIC_RELEASE, "agent");
            asm volatile("s_waitcnt vmcnt(0)" ::: "memory");
            const unsigned og = xb_add(&bar[XB_TOP], 1u);
            const unsigned tg = og / nx;
            if (og + 1u == (tg + 1u) * nx) xb_add(&bar[XB_TOPGEN], 1u);
            else XB_SPIN(xb_ld(&bar[XB_TOPGEN]) == tg, bar);
            __builtin_amdgcn_fence(__ATOMIC_ACQUIRE, "agent");
            xb_add(&bar[XB_XGEN(b.x)], 1u);
            asm volatile("s_waitcnt vmcnt(0)" ::: "memory");
        } else {
            XB_SPIN(xb_ld(&bar[XB_XGEN(b.x)]) == gen, bar);
            __builtin_amdgcn_fence(__ATOMIC_ACQUIRE, "agent");
            asm volatile("s_waitcnt vmcnt(0)" ::: "memory");
        }
    }
    __syncthreads();
}

struct Args { const float* in[17]; float* out; unsigned char* ws; double invf_t[64]; double invf_ax[32]; };

__global__ void __launch_bounds__(NWAVES * 64, 2) mega_fwd(Args args) {
    extern __shared__ __attribute__((aligned(16))) unsigned char lds[];
    cg::grid_group grid = cg::this_grid();
    const int tid = threadIdx.x, lane = tid & 63, wave = __builtin_amdgcn_readfirstlane(tid >> 6);
    const int G = gridDim.x, bx = blockIdx.x;
    const int vcu = (G % 8 == 0) ? (bx % 8) * (G / 8) + bx / 8 : bx;
    const int gw = vcu * NWAVES + wave, NGW = G * NWAVES;
    unsigned char* ws = args.ws;
    const float* x_prompt = args.in[0]; const float* x_sample = args.in[1];
    const float* norm_pre_mix = args.in[2]; const float* w_in = args.in[3]; const float* q_norm_a = args.in[4]; const float* k_norm_a = args.in[5];
    const float* sink_b = args.in[6]; const float* w_branch_a = args.in[7]; const float* w_branch_b = args.in[8]; const float* w_out = args.in[9];
    const float* norm_post_mix = args.in[10]; const float* norm_pre_ffn = args.in[11]; const float* w_up = args.in[12]; const float* conv_w = args.in[13];
    const float* conv_b = args.in[14]; const float* w_down = args.in[15]; const float* norm_post_ffn = args.in[16];
    float* out = args.out;
    bf16r* WinT = (bf16r*)(ws + WS_WIN); bf16r* WaT = (bf16r*)(ws + WS_WA); bf16r* WbT = (bf16r*)(ws + WS_WB); bf16r* WoutT = (bf16r*)(ws + WS_WOUT);
    bf16r* WupT = (bf16r*)(ws + WS_WUP); bf16r* WdownT = (bf16r*)(ws + WS_WDOWN);
    bf16r* Hb = (bf16r*)(ws + WS_H);

    unsigned* barw = (unsigned*)(ws + 65536);
    volatile LAS unsigned* bar_st = (volatile LAS unsigned*)((LAS unsigned char*)lds + 143360);
    if (bx == 0) for (int i = tid; i < XCD_BAR_WORDS; i += NWAVES * 64) barw[i] = 0u;
    if (tid < 2) bar_st[tid] = 0u;
    XcdBarrier xbar;
#define GRID_BAR() xcd_barrier(xbar)
#ifndef SKIP_0
    for (int rep_ = 0; rep_ < (REP_PHASE == 0 ? 2 : 1); ++rep_) {
        LAS float* scr = (LAS float*)((LAS unsigned char*)lds + wave * 16384);
        constexpr int I_IN = (DM / 64) * (NIN / 32), I_A = (1024 / 64) * (DM / 32), I_OUT = (DM / 64) * (DM / 32), I_UP = (DM / 64) * (NUP / 32), I_DN = (DFF / 64) * (DM / 32);
        constexpr int NITEMS = I_IN + 2 * I_A + I_OUT + I_UP + I_DN;
        for (int it = gw; it < NITEMS; it += NGW) {
            int r = it;
            if (r < I_IN) { transpose_item<1>(w_in, DM, NIN, WinT, scr, r, lane); continue; } r -= I_IN;
            if (r < I_A) { transpose_item<0>(w_branch_a, 1024, DM, WaT, scr, r, lane); continue; } r -= I_A;
            if (r < I_A) { transpose_item<0>(w_branch_b, 1024, DM, WbT, scr, r, lane); continue; } r -= I_A;
            if (r < I_OUT) { transpose_item<0>(w_out, DM, DM, WoutT, scr, r, lane); continue; } r -= I_OUT;
            if (r < I_UP) { transpose_item<2>(w_up, DM, NUP, WupT, scr, r, lane); continue; } r -= I_UP;
            transpose_item<0>(w_down, DFF, DM, WdownT, scr, r, lane);
        }
        float* cost = (float*)(ws + WS_COST); float* sint = (float*)(ws + WS_SINT); float* ax = (float*)(ws + WS_AX);
        for (int e = vcu * 512 + tid; e < 8192 * 64; e += G * 512) { const int t = e >> 6, i = e & 63; double a = (double)t * args.invf_t[i]; a -= floor(a); const float fr = (float)a;
            cost[e] = __builtin_amdgcn_cosf(fr); sint[e] = __builtin_amdgcn_sinf(fr); }
        for (int e = vcu * 512 + tid; e < 128 * 32 + 64 * 32; e += G * 512) {
            const bool isrow = e < 128 * 32; const int e2 = isrow ? e : e - 128 * 32; const int pos = e2 >> 5, i = e2 & 31;
            double a = (double)pos * args.invf_ax[i]; a -= floor(a); const float fr = (float)a;
            const float c = __builtin_amdgcn_cosf(fr), s = __builtin_amdgcn_sinf(fr);
            if (isrow) { ax[e2] = c; ax[4096 + e2] = s; } else { ax[8192 + e2] = c; ax[10240 + e2] = s; } }
        for (int e = vcu * 512 + tid; e < NPAD; e += G * 512) ((int*)(ws + WS_TOKMAP))[e] = pg8::conv_row_token(e);
        for (int m0 = gw; m0 < NTOK; m0 += ROWS_P0 * NGW) {
            v4f v[ROWS_P0][8];
#pragma unroll
            for (int r = 0; r < ROWS_P0; ++r) { const int m = m0 + r * NGW; if (m < NTOK) { const v4f* xr = (const v4f*)xrow_ptr(x_prompt, x_sample, m) + lane;
#pragma unroll
                for (int j = 0; j < 8; ++j) v[r][j] = __builtin_nontemporal_load(xr + 64 * j); } }
#pragma unroll
            for (int r = 0; r < ROWS_P0; ++r) { const int m = m0 + r * NGW; if (m >= NTOK) continue;
                float s = 0.f;
#pragma unroll
                for (int j = 0; j < 8; ++j) s += (v[r][j].x * v[r][j].x + v[r][j].y * v[r][j].y) + (v[r][j].z * v[r][j].z + v[r][j].w * v[r][j].w);
                const float rstd = 1.f / sqrtf(wave_sum(s) * (1.f / DM) + RMS_EPS);
                unsigned long long* o8 = (unsigned long long*)(Hb + (size_t)m * DM) + lane;
#pragma unroll
                for (int j = 0; j < 8; ++j) { const v4f g = *((const v4f*)norm_pre_mix + lane + 64 * j);
                    o8[64 * j] = (unsigned long long)pk2(v[r][j].x * rstd * g.x, v[r][j].y * rstd * g.y) | ((unsigned long long)pk2(v[r][j].z * rstd * g.z, v[r][j].w * rstd * g.w) << 32); } }
        }
    }
#endif
    grid.sync();
    xbar = xcd_barrier_post(barw, bar_st);

#ifdef EXTRA_SYNCS
    for (int q_ = 0; q_ < EXTRA_SYNCS; ++q_) grid.sync();
#endif
#ifndef SKIP_1
    for (int rep_ = 0; rep_ < (REP_PHASE == 1 ? 2 : 1); ++rep_) {
        pg8::Gemm g{Hb, WinT, NTOK, NIN, DM, nullptr, nullptr}; pg8::StaticOrder S; S.init(NTOK, NIN, G, bx, WGM_P1);
        pg8::EpiProj E{ws, q_norm_a, k_norm_a, (LAS float*)((LAS unsigned char*)lds + 131072)};
        pg8::gemm_phase<pg8::EpiProj, pg8::StaticOrder, true, true, false>((LAS unsigned char*)lds, g, S, E);
    }
#endif
    GRID_BAR();

#ifndef SKIP_3
    for (int rep_ = 0; rep_ < (REP_PHASE == 3 ? 2 : 1); ++rep_) {
        using abf = att::bf16;
        const abf* qA = (const abf*)(ws + WS_QA); const abf* kA = (const abf*)(ws + WS_KA); const abf* vA = (const abf*)(ws + WS_VA);
        const abf* qB = (const abf*)(ws + WS_QB); const abf* kB = (const abf*)(ws + WS_KB); const abf* vB = (const abf*)(ws + WS_VB);
        abf* oA = (abf*)(ws + WS_OA); abf* oB = (abf*)(ws + WS_OB);
#ifndef SKIP_DP
        for (int i = 0; i < 6; ++i) {
            size_t tok0, kr; int h, NT;
            if (i < 4) { const int u = vcu * 4 + i; const int bh = u >> 5, qb = u & 31, b = bh >> 3; h = bh & 7; kr = (size_t)b * 8192; tok0 = kr + qb * 256; NT = 128; }
            else { const int u = vcu * 2 + (i - 4); const int bh = u >> 3, qb = u & 7, b = bh >> 3; h = bh & 7; kr = (size_t)NPROMPT + (size_t)b * 2048; tok0 = kr + qb * 256; NT = 32; }
            att::attn_unit<false, SD_DENSE>(qA + tok0 * 1024 + h * 128, kA + kr * 256 + (h >> 2) * 128, vA + kr * 256 + (h >> 2) * 128, oA + tok0 * 1024 + h * 128, NT, (char*)lds, 0, 0.f); }
        for (int i = 0; i < 6; ++i) {
            const int u = vcu * 6 + i; const int tb = u >> 3, h = u & 7; const int t0 = tb * 256; int sbase, SL;
            if (t0 < NPROMPT) { sbase = t0 & ~8191; SL = 8192; } else { sbase = NPROMPT + ((t0 - NPROMPT) & ~2047); SL = 2048; }
            const int q0 = t0 - sbase; const int kt0 = q0 >= 128 ? q0 - 128 : 0; const int kt1 = (q0 + 384 <= SL) ? q0 + 384 : SL; const int NT = (kt1 - kt0) >> 6;
            const size_t kr = (size_t)sbase + kt0, tok0 = (size_t)t0;
            att::attn_unit<true, SD_WIN>(qB + tok0 * 1024 + h * 128, kB + kr * 256 + (h >> 2) * 128, vB + kr * 256 + (h >> 2) * 128, oB + tok0 * 1024 + h * 128, NT, (char*)lds, kt0 - q0, sink_b[h]); }
#endif
        __syncthreads();
    }
#endif
    GRID_BAR();

#ifndef SKIP_4
    for (int rep_ = 0; rep_ < (REP_PHASE == 4 ? 2 : 1); ++rep_) {
        pg8::PairOrder S; S.base.init(NTOK, DM, G, bx, WGM_P3);
        pg8::Gemm g{(const bf16r*)(ws + WS_OA), WaT, NTOK, DM, 1024, (const bf16r*)(ws + WS_OB), WbT};
        pg8::EpiGate2 E{(const bf16r*)(ws + WS_GA), (const bf16r*)(ws + WS_GB), (bf16r*)(ws + WS_MERGED)};
        pg8::gemm_phase<pg8::EpiGate2, pg8::PairOrder, true, true, false, true>((LAS unsigned char*)lds, g, S, E);
    }
#endif
    GRID_BAR();

#ifndef SKIP_5
    for (int rep_ = 0; rep_ < (REP_PHASE == 5 ? 2 : 1); ++rep_) {
        pg8::Gemm g{(const bf16r*)(ws + WS_MERGED), WoutT, NTOK, DM, DM, nullptr, nullptr}; pg8::StaticOrder S; S.init(NTOK, DM, G, bx, WGM_P3C);
        pg8::EpiBf16Plain E{(bf16r*)(ws + WS_MIX)};
        pg8::gemm_phase<pg8::EpiBf16Plain, pg8::StaticOrder, true, true, false>((LAS unsigned char*)lds, g, S, E);
    }
#endif
    GRID_BAR();

#ifndef SKIP_6
    {
        int lnL = lane; asm volatile("" : "+v"(lnL));
        for (int P0 = gw; P0 < NPAD; P0 += 2 * NGW) {
            v4f mv[2][8], xv[2][8]; int tokr[2]; bool istok[2];
#pragma unroll
            for (int r = 0; r < 2; ++r) { const int P = P0 + r * NGW; istok[r] = false; tokr[r] = 0;
                if (P < NPAD) { const int tk = ((const int*)(ws + WS_TOKMAP))[P];
                    if (tk >= 0) { istok[r] = true; tokr[r] = tk;
                        const v2u* mrow = (const v2u*)((const bf16r*)(ws + WS_MIX) + (size_t)tokr[r] * DM) + lnL; const v4f* xr = (const v4f*)xrow_ptr(x_prompt, x_sample, tokr[r]) + lnL;
#pragma unroll
                        for (int j = 0; j < 8; ++j) { const v2u w = __builtin_nontemporal_load(mrow + 64 * j); mv[r][j] = (v4f){pg8::bf_lo(w.x), pg8::bf_hi(w.x), pg8::bf_lo(w.y), pg8::bf_hi(w.y)}; xv[r][j] = __builtin_nontemporal_load(xr + 64 * j); } } } }
#pragma unroll
            for (int r = 0; r < 2; ++r) { const int P = P0 + r * NGW; if (P >= NPAD) continue;
                unsigned long long* o8 = (unsigned long long*)(Hb + (size_t)P * DM) + lnL;
                if (!istok[r]) {
#pragma unroll
                    for (int j = 0; j < 8; ++j) o8[64 * j] = 0ull;
                    continue; }
                unsigned long long* x1row = (unsigned long long*)(tokr[r] < X1_SPLIT ? ws + WS_X1A + (size_t)tokr[r] * (DM * 2) : ws + WS_X1B + (size_t)(tokr[r] - X1_SPLIT) * (DM * 2)) + lnL;
                float s = 0.f;
#pragma unroll
                for (int j = 0; j < 8; ++j) s += (mv[r][j].x * mv[r][j].x + mv[r][j].y * mv[r][j].y) + (mv[r][j].z * mv[r][j].z + mv[r][j].w * mv[r][j].w);
                const float rstd = 1.f / sqrtf(wave_sum(s) * (1.f / DM) + RMS_EPS);
                float s2 = 0.f;
#pragma unroll
                for (int j = 0; j < 8; ++j) { const v4f g = *((const v4f*)norm_post_mix + lnL + 64 * j); const v4f x1 = xv[r][j] + mv[r][j] * rstd * g; mv[r][j] = x1; __builtin_nontemporal_store((unsigned long long)pk2(x1.x, x1.y) | ((unsigned long long)pk2(x1.z, x1.w) << 32), x1row + 64 * j);
                    s2 += (x1.x * x1.x + x1.y * x1.y) + (x1.z * x1.z + x1.w * x1.w); }
                const float rstd2 = 1.f / sqrtf(wave_sum(s2) * (1.f / DM) + RMS_EPS);
#pragma unroll
                for (int j = 0; j < 8; ++j) { const v4f g = *((const v4f*)norm_pre_ffn + lnL + 64 * j); const v4f x1 = mv[r][j];
                    o8[64 * j] = (unsigned long long)pk2(x1.x * rstd2 * g.x, x1.y * rstd2 * g.y) | ((unsigned long long)pk2(x1.z * rstd2 * g.z, x1.w * rstd2 * g.w) << 32); } }
        }
    }
#endif
    GRID_BAR();

#ifndef SKIP_7
    for (int rep_ = 0; rep_ < (REP_PHASE == 7 ? 2 : 1); ++rep_) {
        pg8::Gemm g{Hb, WupT, MT_UP * 256, NUP, DM, nullptr, nullptr}; pg8::StaticOrder S; S.init(MT_UP * 256, NUP, G, bx, WGM_P4);
        pg8::EpiConv E{conv_w, conv_b, (bf16r*)(ws + WS_ACT), (const int*)(ws + WS_TOKMAP)};
        pg8::gemm_phase<pg8::EpiConv, pg8::StaticOrder, P4_ALIGN, true, true>((LAS unsigned char*)lds, g, S, E);
    }
#endif
    GRID_BAR();

#ifndef SKIP_8
    for (int rep_ = 0; rep_ < (REP_PHASE == 8 ? 2 : 1); ++rep_) {
        pg8::Gemm g{(const bf16r*)(ws + WS_ACT), WdownT, NTOK, DM, DFF, nullptr, nullptr}; pg8::StaticOrder S; S.init(NTOK, DM, G, bx, WGM_P5);
        pg8::EpiBf16Plain E{Hb};
        pg8::gemm_phase<pg8::EpiBf16Plain, pg8::StaticOrder, true, true, false>((LAS unsigned char*)lds, g, S, E);
    }
#endif
    GRID_BAR();

#ifndef SKIP_9
    {
        int lnL = lane; asm volatile("" : "+v"(lnL));
        for (int m0 = gw; m0 < NTOK; m0 += ROWS_P6 * NGW) {
            v4u fw[ROWS_P6][4]; v4u xw[ROWS_P6][4];
#pragma unroll
            for (int r = 0; r < ROWS_P6; ++r) { const int m = m0 + r * NGW; if (m < NTOK) { const v4u* fr_ = (const v4u*)(Hb + (size_t)m * DM) + lnL; const v4u* xr_ = (const v4u*)(m < X1_SPLIT ? ws + WS_X1A + (size_t)m * (DM * 2) : ws + WS_X1B + (size_t)(m - X1_SPLIT) * (DM * 2)) + lnL;
#pragma unroll
                for (int c = 0; c < 4; ++c) { fw[r][c] = __builtin_nontemporal_load(fr_ + 64 * c); xw[r][c] = __builtin_nontemporal_load(xr_ + 64 * c); } } }
#pragma unroll
            for (int r = 0; r < ROWS_P6; ++r) { const int m = m0 + r * NGW; if (m >= NTOK) continue;
                float f[4][8]; float s = 0.f;
#pragma unroll
                for (int c = 0; c < 4; ++c) { const v4u w = fw[r][c];
                    f[c][0] = pg8::bf_lo(w.x); f[c][1] = pg8::bf_hi(w.x); f[c][2] = pg8::bf_lo(w.y); f[c][3] = pg8::bf_hi(w.y); f[c][4] = pg8::bf_lo(w.z); f[c][5] = pg8::bf_hi(w.z); f[c][6] = pg8::bf_lo(w.w); f[c][7] = pg8::bf_hi(w.w);
#pragma unroll
                    for (int e = 0; e < 8; ++e) s += f[c][e] * f[c][e]; }
                const float rstd = 1.f / sqrtf(wave_sum(s) * (1.f / DM) + RMS_EPS);
                float* orow = out + (size_t)m * DM;
#pragma unroll
                for (int c = 0; c < 4; ++c) { const int e0 = 8 * lnL + 512 * c;
                    const v4f g0 = *(const v4f*)(norm_post_ffn + e0), g1 = *(const v4f*)(norm_post_ffn + e0 + 4);
                    const v4u xq = xw[r][c]; v4f a0 = {pg8::bf_lo(xq.x), pg8::bf_hi(xq.x), pg8::bf_lo(xq.y), pg8::bf_hi(xq.y)}, a1 = {pg8::bf_lo(xq.z), pg8::bf_hi(xq.z), pg8::bf_lo(xq.w), pg8::bf_hi(xq.w)};
                    a0.x += f[c][0] * rstd * g0.x; a0.y += f[c][1] * rstd * g0.y; a0.z += f[c][2] * rstd * g0.z; a0.w += f[c][3] * rstd * g0.w;
                    a1.x += f[c][4] * rstd * g1.x; a1.y += f[c][5] * rstd * g1.y; a1.z += f[c][6] * rstd * g1.z; a1.w += f[c][7] * rstd * g1.w;
                    __builtin_nontemporal_store(a0, (v4f*)(orow + e0)); __builtin_nontemporal_store(a1, (v4f*)(orow + e0 + 4)); } }
        }
    }
#endif
}

extern "C" void kernel_launch(void* const* d_in, const int* in_sizes, int n_in, void* d_out, int out_size, void* d_ws, size_t ws_size, hipStream_t stream) {
    static int grid = 0;
    if (grid == 0) {
        if (n_in != 17 || ws_size < WS_END || out_size != NTOK * DM || in_sizes[0] != NPROMPT * DM) { fprintf(stderr, "kernel_launch: bad shapes n_in %d ws %zu out %d\n", n_in, ws_size, out_size); grid = -1; return; }
        int dev = 0, cus = 0, per_cu = 0;
        hipGetDevice(&dev);
        hipDeviceGetAttribute(&cus, hipDeviceAttributeMultiprocessorCount, dev);
        if (hipFuncSetAttribute((const void*)mega_fwd, hipFuncAttributeMaxDynamicSharedMemorySize, LDS_BYTES) != hipSuccess) { fprintf(stderr, "kernel_launch: hipFuncSetAttribute failed\n"); grid = -1; return; }
        if (hipOccupancyMaxActiveBlocksPerMultiprocessor(&per_cu, (const void*)mega_fwd, NWAVES * 64, LDS_BYTES) != hipSuccess || per_cu < 1) { fprintf(stderr, "kernel_launch: occupancy query says %d\n", per_cu); }
        (void)hipGetLastError();
        if (cus != 256) { fprintf(stderr, "kernel_launch: built for 256 CUs, found %d\n", cus); grid = -1; return; }
        grid = cus;
    }
    if (grid < 0) return;
    Args a{};
    for (int i = 0; i < 17; ++i) a.in[i] = (const float*)d_in[i];
    a.out = (float*)d_out; a.ws = (unsigned char*)d_ws;
    const double two_pi = 6.283185307179586476925286766559;
    for (int i = 0; i < 64; ++i) a.invf_t[i] = pow(10000.0, -(double)i / 64.0) / two_pi;
    for (int i = 0; i < 32; ++i) a.invf_ax[i] = pow(10000.0, -(double)i / 32.0) / two_pi;
    void* kargs[] = {&a};
    hipError_t e = hipLaunchCooperativeKernel((const void*)mega_fwd, dim3(grid), dim3(NWAVES * 64), kargs, LDS_BYTES, stream);
    if (e != hipSuccess) fprintf(stderr, "kernel_launch: cooperative launch failed: %s (grid %d)\n", hipGetErrorString(e), grid);
}
```

```cpp
#define SD_DENSE 1
#define SD_WIN 1
#define P4_ALIGN true
#define WGM_P4 6
#include <hip/hip_runtime.h>
#include <hip/hip_cooperative_groups.h>
#include <hip/hip_bf16.h>
#include <cstdio>
#include <cstdint>
#include <cmath>
namespace cg = cooperative_groups;

constexpr int NTOK = 49152, NPROMPT = 32768, DM = 2048, NIN = 7168, DFF = 5632, NUP = 11264;
constexpr int MT_UP = 194, NPAD = 254 * (MT_UP - 1) + 256 + 2;
constexpr size_t WS_TOKMAP = 131072;
constexpr float RMS_EPS = 1e-6f;
constexpr size_t MiB = 1u << 20;
constexpr size_t WS_COST = 1 * MiB, WS_SINT = 3 * MiB, WS_AX = 5 * MiB;
constexpr size_t WS_WIN = 6 * MiB, WS_WA = 34 * MiB, WS_WB = 38 * MiB, WS_WOUT = 42 * MiB, WS_WUP = 50 * MiB, WS_WDOWN = 94 * MiB;
constexpr size_t WS_SSQ = 116 * MiB;
constexpr size_t WS_H = 124 * MiB;
constexpr size_t WS_OA = 124 * MiB, WS_OB = 220 * MiB;
constexpr size_t WS_QA = 320 * MiB, WS_KA = 416 * MiB, WS_VA = 440 * MiB, WS_QB = 464 * MiB, WS_KB = 560 * MiB, WS_VB = 584 * MiB, WS_GA = 608 * MiB, WS_GB = 800 * MiB;
constexpr size_t WS_MIX = 512 * MiB;
constexpr size_t WS_X1A = 848 * MiB, WS_X1B = 6 * MiB; constexpr int X1_SPLIT = 45056;
constexpr size_t WS_MERGED = 320 * MiB, WS_ACT = 320 * MiB, WS_END = 1024 * MiB;
static_assert(WS_H + (size_t)NPAD * DM * 2 <= WS_QA && WS_ACT + (size_t)NTOK * DFF * 2 <= WS_END && WS_GB + (size_t)NTOK * DM * 2 <= WS_END, "ws map");
constexpr int LDS_BYTES = 147456;

namespace pg8 {
#define PG8_LAS __attribute__((address_space(3)))
typedef unsigned short bf16_t;
typedef short bf16x8 __attribute__((ext_vector_type(8)));
typedef float f32x4 __attribute__((ext_vector_type(4)));
typedef unsigned u32x4 __attribute__((ext_vector_type(4)));
constexpr int BM = 256, BK = 64, HALF = 128, HTB = HALF * BK * 2  , STAGE_BYTES = 8 * HTB, NXCD = 8, WGM = 8;

__host__ __device__ __forceinline__ int lds_byte(int r, int c) { const int st = (r >> 4) * 2 + (c >> 5), rr = r & 15, cc = c & 31, ob = rr * 64 + cc * 2; return st * 1024 + (ob ^ (((ob >> 9) & 1) << 5)); }
__host__ __device__ __forceinline__ void stage_rc(int b, int& R, int& C) { const int st = b / 1024, sb = b % 1024, swz = sb ^ (((sb >> 9) & 1) << 5); R = (st >> 1) * 16 + swz / 64; C = (st & 1) * 32 + (swz % 64) / 2; }
__host__ __device__ __forceinline__ int perm32(int rho) { const int n = rho >> 4, i = rho & 15; return 8 * (i >> 2) + 4 * n + (i & 3); }

struct Unit { int pm, pn, sel; };
struct Gemm { const bf16_t* A; const bf16_t* Bt; int M, N, K; const bf16_t* A2; const bf16_t* Bt2; };

struct StaticOrder {
    int nM, nN, nwg, G, c, wgm;
    __host__ __device__ void init(int M, int N, int G_, int c_, int wgm_ = WGM) { nM = M / BM; nN = N / BM; nwg = nM * nN; G = G_; c = c_; wgm = wgm_; }
    __host__ __device__ bool next(int i, Unit& u) const {
        const long L = (long)i * G + c; if (L >= nwg) return false;
        int wgid = (int)L; { const int q = nwg / NXCD, r = nwg % NXCD, xcd = wgid % NXCD, off = wgid / NXCD; wgid = (xcd < r ? xcd * (q + 1) : r * (q + 1) + (xcd - r) * q) + off; }
        const int nig = wgm * nN, gid = wgid / nig, fm = gid * wgm, gsz = (nM - fm) < wgm ? (nM - fm) : wgm;
        u.pm = fm + ((wgid % nig) % gsz); u.pn = (wgid % nig) / gsz; u.sel = 0; return true;
    }
    __device__ __forceinline__ void a_ready(const Unit&) const {}
    __device__ __forceinline__ void done(const Unit&) const {}
};
struct PairOrder {
    StaticOrder base;
    __host__ __device__ bool next(int i, Unit& u) const { const bool ok = base.next(i >> 1, u); u.sel = i & 1; return ok; }
    __device__ __forceinline__ void a_ready(const Unit&) const {}
    __device__ __forceinline__ void done(const Unit&) const {}
};

__device__ __forceinline__ unsigned cvt_pk_bf16(float lo, float hi) { unsigned r; asm volatile("v_cvt_pk_bf16_f32 %0, %1, %2" : "=v"(r) : "v"(lo), "v"(hi)); return r; }
typedef float f32x2 __attribute__((ext_vector_type(2)));
typedef unsigned u32x2 __attribute__((ext_vector_type(2)));
__device__ __forceinline__ float bf_lo(unsigned w) { return __uint_as_float(w << 16); }
__device__ __forceinline__ float bf_hi(unsigned w) { return __uint_as_float(w & 0xffff0000u); }
__device__ __forceinline__ float sigmoidf_(float v) { return __builtin_amdgcn_rcpf(1.0f + __builtin_amdgcn_exp2f(-1.4426950408889634f * v)); }
__device__ __forceinline__ u32x4 pack8(const f32x4 v0, const f32x4 v1) { u32x4 w; w.x = cvt_pk_bf16(v0[0], v0[1]); w.y = cvt_pk_bf16(v0[2], v0[3]); w.z = cvt_pk_bf16(v1[0], v1[1]); w.w = cvt_pk_bf16(v1[2], v1[3]); return w; }

struct EpiProj {
    static constexpr bool PERM = true, AFTER_DRAIN = false;
    unsigned char* ws; const float* qg; const float* kg; PG8_LAS float* xl;
    __device__ __forceinline__ void operator()(const f32x4 (&acc)[2][2][4][2], const Unit& u, int wr, int wc, int fr, int fq) const {
        const int pn = u.pn;
        int mode, ld, colt, hbase = 0; size_t boff; const float* gain = qg;
        if (pn < 4)        { mode = 1; boff = WS_QA; ld = 1024; colt = pn * 256; hbase = 2 * pn; }
        else if (pn == 4)  { mode = 1; boff = WS_KA; ld = 256;  colt = 0; hbase = 8; gain = kg; }
        else if (pn == 5)  { mode = 0; boff = WS_VA; ld = 256;  colt = 0; }
        else if (pn < 10)  { mode = 2; boff = WS_QB; ld = 1024; colt = (pn - 6) * 256; }
        else if (pn == 10) { mode = 2; boff = WS_KB; ld = 256;  colt = 0; }
        else if (pn == 11) { mode = 0; boff = WS_VB; ld = 256;  colt = 0; }
        else if (pn < 20)  { mode = 3; boff = WS_GA; ld = 2048; colt = (pn - 12) * 256; }
        else               { mode = 3; boff = WS_GB; ld = 2048; colt = (pn - 20) * 256; }
        bf16_t* base = (bf16_t*)(ws + boff);
        const int col0 = colt + wc * 32 + 8 * fq;
        const int row0 = u.pm * BM + wr * 64 + fr;
        if (mode == 0 || mode == 3) {
#pragma unroll
            for (int ai = 0; ai < 2; ++ai)
#pragma unroll
                for (int m = 0; m < 4; ++m) { bf16_t* rowp = base + (size_t)(row0 + ai * HALF + m * 16) * ld + col0;
#pragma unroll
                    for (int bj = 0; bj < 2; ++bj) { f32x4 v0 = acc[ai][bj][m][0], v1 = acc[ai][bj][m][1];
                        if (mode == 3) {
#pragma unroll
                            for (int j = 0; j < 4; ++j) { v0[j] = sigmoidf_(v0[j]); v1[j] = sigmoidf_(v1[j]); } }
                        *(u32x4*)(rowp + bj * HALF) = pack8(v0, v1); } }
        } else if (mode == 2) {
            const float* ct = (const float*)(ws + WS_COST) + wc * 16 + fq * 4; const float* st = (const float*)(ws + WS_SINT) + wc * 16 + fq * 4;
#pragma unroll
            for (int ai = 0; ai < 2; ++ai)
#pragma unroll
                for (int m = 0; m < 4; ++m) { const int tok = row0 + ai * HALF + m * 16; const int t = tok < NPROMPT ? (tok & 8191) : (tok & 2047);
                    const f32x4 c = *(const f32x4*)(ct + t * 64), s = *(const f32x4*)(st + t * 64);
                    bf16_t* rowp = base + (size_t)tok * ld + col0;
#pragma unroll
                    for (int bj = 0; bj < 2; ++bj) { const f32x4 lo = acc[ai][bj][m][0], hi = acc[ai][bj][m][1];
                        *(u32x4*)(rowp + bj * HALF) = pack8(lo * c - hi * s, hi * c + lo * s); } }
        } else {
            const int dlo = 64 * (wc >> 1) + 16 * (wc & 1) + 4 * fq;
            const f32x4 glo = *(const f32x4*)(gain + dlo), ghi = *(const f32x4*)(gain + dlo + 32);
            const float* axt = (const float*)(ws + WS_AX) + ((wc >> 1) ? 8192 : 0);
            const int sinoff = (wc >> 1) ? 2048 : 4096, fi = 16 * (wc & 1) + 4 * fq;
            PG8_LAS float* xq = xl + ((wr * 64 + fr) * 2) * 4 + wc;
#pragma unroll
            for (int ai = 0; ai < 2; ++ai)
#pragma unroll
                for (int m = 0; m < 4; ++m)
#pragma unroll
                    for (int bj = 0; bj < 2; ++bj) { const f32x4 r0 = acc[ai][bj][m][0], r1 = acc[ai][bj][m][1];
                        float q = (r0[0] * r0[0] + r0[1] * r0[1]) + (r0[2] * r0[2] + r0[3] * r0[3]) + (r1[0] * r1[0] + r1[1] * r1[1]) + (r1[2] * r1[2] + r1[3] * r1[3]);
                        q += __shfl_xor(q, 16); q += __shfl_xor(q, 32);
                        if (fq == 0) xq[((ai * HALF + m * 16) * 2 + bj) * 4] = q; }
            asm volatile("s_waitcnt lgkmcnt(0)" ::: "memory"); __builtin_amdgcn_s_barrier(); asm volatile("" ::: "memory");
#pragma unroll
            for (int ai = 0; ai < 2; ++ai)
#pragma unroll
                for (int m = 0; m < 4; ++m) { const int tok = row0 + ai * HALF + m * 16; const int t = tok < NPROMPT ? (tok & 8191) : (tok & 2047);
                    const int pos = (wc >> 1) ? (t & 63) : (t >> 6);
                    const f32x4 c = *(const f32x4*)(axt + pos * 32 + fi), s = *(const f32x4*)(axt + sinoff + pos * 32 + fi);
                    bf16_t* rowp = base + (size_t)tok * ld + col0;
#pragma unroll
                    for (int bj = 0; bj < 2; ++bj) {
                        const f32x4 pp = *(const PG8_LAS f32x4*)(xl + ((wr * 64 + fr + ai * HALF + m * 16) * 2 + bj) * 4);
                        const float rstd = 1.0f / sqrtf(((pp[0] + pp[1]) + (pp[2] + pp[3])) * (1.0f / 128.0f) + RMS_EPS);
                        const f32x4 lo = acc[ai][bj][m][0] * glo * rstd, hi = acc[ai][bj][m][1] * ghi * rstd;
                        *(u32x4*)(rowp + bj * HALF) = pack8(lo * c - hi * s, hi * c + lo * s); } }
        }
    }
};

struct EpiGate2 {
    static constexpr bool PERM = true, AFTER_DRAIN = false;
    const bf16_t* ga; const bf16_t* gb; bf16_t* merged;
    __device__ __forceinline__ void mid(f32x4 (&acc)[2][2][4][2], const Unit& u, int wr, int wc, int fr, int fq) const {
        const int row0 = u.pm * BM + wr * 64 + fr, col0 = u.pn * BM + wc * 32 + 8 * fq;
#pragma unroll
        for (int ai = 0; ai < 2; ++ai)
#pragma unroll
            for (int m = 0; m < 4; ++m) { const size_t off = (size_t)(row0 + ai * HALF + m * 16) * DM + col0;
#pragma unroll
                for (int bj = 0; bj < 2; ++bj) { const u32x4 a = __builtin_nontemporal_load((const u32x4*)(ga + off + bj * HALF)), b = *(const u32x4*)(gb + off + bj * HALF);
                    const f32x4 a0 = {bf_lo(a.x), bf_hi(a.x), bf_lo(a.y), bf_hi(a.y)}, a1 = {bf_lo(a.z), bf_hi(a.z), bf_lo(a.w), bf_hi(a.w)};
                    f32x4 b0 = {bf_lo(b.x), bf_hi(b.x), bf_lo(b.y), bf_hi(b.y)}, b1 = {bf_lo(b.z), bf_hi(b.z), bf_lo(b.w), bf_hi(b.w)};
#pragma unroll
                    for (int j = 0; j < 4; ++j) { b0[j] = __builtin_amdgcn_rcpf(fmaxf(b0[j], 1e-30f)); b1[j] = __builtin_amdgcn_rcpf(fmaxf(b1[j], 1e-30f)); }
                    acc[ai][bj][m][0] = acc[ai][bj][m][0] * (a0 * b0); acc[ai][bj][m][1] = acc[ai][bj][m][1] * (a1 * b1); } }
    }
    __device__ __forceinline__ void operator()(const f32x4 (&acc)[2][2][4][2], const Unit& u, int wr, int wc, int fr, int fq) const {
        const int row0 = u.pm * BM + wr * 64 + fr, col0 = u.pn * BM + wc * 32 + 8 * fq;
#pragma unroll
        for (int ai = 0; ai < 2; ++ai)
#pragma unroll
            for (int m = 0; m < 4; ++m) { const size_t off = (size_t)(row0 + ai * HALF + m * 16) * DM + col0;
#pragma unroll
                for (int bj = 0; bj < 2; ++bj) { const u32x4 b = *(const u32x4*)(gb + off + bj * HALF);
                    f32x4 b0 = {bf_lo(b.x), bf_hi(b.x), bf_lo(b.y), bf_hi(b.y)}, b1 = {bf_lo(b.z), bf_hi(b.z), bf_lo(b.w), bf_hi(b.w)};
#pragma unroll
                    for (int j = 0; j < 4; ++j) { b0[j] = fmaxf(b0[j], 1e-30f); b1[j] = fmaxf(b1[j], 1e-30f); }
                    *(u32x4*)(merged + off + bj * HALF) = pack8(acc[ai][bj][m][0] * b0, acc[ai][bj][m][1] * b1); } }
    }
};
struct EpiF32 {
    static constexpr bool PERM = true, AFTER_DRAIN = false;
    float* O;
    __device__ __forceinline__ void operator()(const f32x4 (&acc)[2][2][4][2], const Unit& u, int wr, int wc, int fr, int fq) const {
        const int row0 = u.pm * BM + wr * 64 + fr, col0 = u.pn * BM + wc * 32 + 8 * fq;
#pragma unroll
        for (int ai = 0; ai < 2; ++ai)
#pragma unroll
            for (int m = 0; m < 4; ++m) { float* rowp = O + (size_t)(row0 + ai * HALF + m * 16) * DM + col0;
#pragma unroll
                for (int bj = 0; bj < 2; ++bj) { *(f32x4*)(rowp + bj * HALF) = acc[ai][bj][m][0]; *(f32x4*)(rowp + bj * HALF + 4) = acc[ai][bj][m][1]; } }
    }
};
struct EpiBf16Plain {
    static constexpr bool PERM = true, AFTER_DRAIN = false;
    bf16_t* O;
    __device__ __forceinline__ void operator()(const f32x4 (&acc)[2][2][4][2], const Unit& u, int wr, int wc, int fr, int fq) const {
        const int row0 = u.pm * BM + wr * 64 + fr, col0 = u.pn * BM + wc * 32 + 8 * fq;
#pragma unroll
        for (int ai = 0; ai < 2; ++ai)
#pragma unroll
            for (int m = 0; m < 4; ++m) { bf16_t* rowp = O + (size_t)(row0 + ai * HALF + m * 16) * DM + col0;
#pragma unroll
                for (int bj = 0; bj < 2; ++bj) *(u32x4*)(rowp + bj * HALF) = pack8(acc[ai][bj][m][0], acc[ai][bj][m][1]); }
    }
};
__device__ __forceinline__ float dpp_shr1(float v) { return __builtin_bit_cast(float, __builtin_amdgcn_update_dpp(0, __builtin_bit_cast(int, v), 0x111, 0xf, 0xf, true)); }
__device__ __forceinline__ float dpp_shl1(float v) { return __builtin_bit_cast(float, __builtin_amdgcn_update_dpp(0, __builtin_bit_cast(int, v), 0x101, 0xf, 0xf, true)); }
__device__ __forceinline__ float dpp_mirror(float v) { return __builtin_bit_cast(float, __builtin_amdgcn_update_dpp(0, __builtin_bit_cast(int, v), 0x140, 0xf, 0xf, true)); }
__device__ __forceinline__ float gelu_tanh_(float a) { const float u2 = a * (1.5957691216f + 0.0713548163f * a * a); return a * __builtin_amdgcn_rcpf(1.0f + __builtin_amdgcn_exp2f(-1.4426950408889634f * u2)); }
__host__ __device__ __forceinline__ int conv_row_token(int P) {
    if (P < 32772) { const int s = P / 8193, r = P - 8193 * s; return r >= 1 ? 8192 * s + r - 1 : -1; }
    if (P < 49165) { const int Q = P - 32772, s2 = Q / 2049, r = Q - 2049 * s2; return r >= 1 ? NPROMPT + 2048 * s2 + r - 1 : -1; }
    return -1;
}
struct EpiConv {
    static constexpr bool PERM = true, AFTER_DRAIN = false;
    const float* cw; const float* cb; bf16_t* act; const int* tokmap;
    __device__ __forceinline__ void operator()(const f32x4 (&acc)[2][2][4][2], const Unit& u, int wr, int wc, int fr, int fq) const {
        PG8_LAS float* const xb = (PG8_LAS float*)131072;
        const int ca0 = u.pn * 128 + wc * 32 + 8 * fq;
        const int cpos = wc * 32 + 8 * fq;
        int tokv[2][4];
        { const int* tm = tokmap + 254 * u.pm + 64 * wr + fr;
#pragma unroll
          for (int ai = 0; ai < 2; ++ai)
#pragma unroll
              for (int m = 0; m < 4; ++m) tokv[ai][m] = tm[128 * ai + 16 * m]; }
#pragma unroll
        for (int ai = 0; ai < 2; ++ai) { const int gi = 2 * ai + wr;
#pragma unroll
            for (int bj = 0; bj < 2; ++bj)
#pragma unroll
                for (int n = 0; n < 2; ++n) {
                    if (fr == 0)  *(PG8_LAS f32x4*)(xb + (gi * 2 + 0) * 256 + 128 * bj + cpos + 4 * n) = acc[ai][bj][0][n];
                    if (fr == 15) *(PG8_LAS f32x4*)(xb + (gi * 2 + 1) * 256 + 128 * bj + cpos + 4 * n) = acc[ai][bj][3][n]; } }
        asm volatile("s_waitcnt lgkmcnt(0)" ::: "memory"); __builtin_amdgcn_s_barrier(); asm volatile("" ::: "memory");
#pragma unroll
        for (int ai = 0; ai < 2; ++ai) {
            const int gi = 2 * ai + wr;
#pragma unroll
            for (int n = 0; n < 2; ++n) {
                const int ca = ca0 + 4 * n;
                f32x4 w0[2], w1[2], w2[2], bb[2];
#pragma unroll
                for (int bj = 0; bj < 2; ++bj) { const int c = ca + bj * DFF; w0[bj] = *(const f32x4*)(cw + c); w1[bj] = *(const f32x4*)(cw + NUP + c); w2[bj] = *(const f32x4*)(cw + 2 * NUP + c); bb[bj] = *(const f32x4*)(cb + c); }
#pragma unroll
                for (int m = 0; m < 4; ++m) {
                    f32x4 cv[2];
#pragma unroll
                    for (int bj = 0; bj < 2; ++bj) {
                        const f32x4 cur = acc[ai][bj][m][n]; f32x4 prv, nxt;
                        f32x4 eprev = {0.f, 0.f, 0.f, 0.f}, enext = {0.f, 0.f, 0.f, 0.f};
                        if (m == 0 && gi > 0) eprev = *(const PG8_LAS f32x4*)(xb + ((gi - 1) * 2 + 1) * 256 + 128 * bj + cpos + 4 * n);
                        if (m == 3 && gi < 3) enext = *(const PG8_LAS f32x4*)(xb + ((gi + 1) * 2 + 0) * 256 + 128 * bj + cpos + 4 * n);
#pragma unroll
                        for (int j = 0; j < 4; ++j) {
                            float p = dpp_shr1(cur[j]), q = dpp_shl1(cur[j]);
                            if (m > 0) { const float e = dpp_mirror(acc[ai][bj][m - 1][n][j]); if (fr == 0) p = e; }
                            else { if (fr == 0) p = eprev[j]; }
                            if (m < 3) { const float e = dpp_mirror(acc[ai][bj][m + 1][n][j]); if (fr == 15) q = e; }
                            else { if (fr == 15) q = enext[j]; }
                            prv[j] = p; nxt[j] = q; }
                        cv[bj] = bb[bj] + w0[bj] * prv + w1[bj] * cur + w2[bj] * nxt;
                    }
                    const int R = 64 * gi + 16 * m + fr;
                    const int tok = tokv[ai][m];
                    if (R >= 1 && R <= 254 && tok >= 0) {
                        u32x2 w; w.x = cvt_pk_bf16(gelu_tanh_(cv[0][0]) * cv[1][0], gelu_tanh_(cv[0][1]) * cv[1][1]); w.y = cvt_pk_bf16(gelu_tanh_(cv[0][2]) * cv[1][2], gelu_tanh_(cv[0][3]) * cv[1][3]);
                        *(u32x2*)(act + (size_t)tok * DFF + ca) = w; }
                }
            }
        }
    }
};

template <class Epi, class Sched, bool ALIGN_EPI = false, bool SP2 = false, bool CONVA = false, bool DUAL = false>
__device__ __forceinline__ void gemm_phase(PG8_LAS unsigned char* lds, const Gemm g, const Sched& S, const Epi& E) {
    int tid_ = threadIdx.x; asm volatile("" : "+v"(tid_));
    const int tid = tid_, wid = __builtin_amdgcn_readfirstlane(tid >> 6), lane = tid & 63, wr = wid >> 2, wc = wid & 3, fr = lane & 15, fq = lane >> 4;
    const int K = g.K, nt = K / BK;
    unsigned voffA[2], voffB[2];
#pragma unroll
    for (int i = 0; i < 2; ++i) { int R, C; stage_rc(tid * 16 + i * 8192, R, C); const int Rb = Epi::PERM ? ((R & ~31) + perm32(R & 31)) : R;
        voffA[i] = (unsigned)(R * K + C) * 2u; voffB[i] = (unsigned)(Rb * K + C) * 2u; }
    const size_t kstep = (size_t)(BK * 2);
    const size_t hstepB = (size_t)HALF * K * 2, hstepA = hstepB;
    const size_t tstepB = 2 * hstepB, tstepA = CONVA ? (size_t)254 * K * 2 : tstepB;
    const unsigned ldsw = (unsigned)wid * 1024u;
    const int aoff = lds_byte(wr * 64 + fr, fq * 8), boff = lds_byte(wc * 32 + fr, fq * 8);
#define PG8_SA(b, h) (((b) * 2 + (h)) * HTB)
#define PG8_SB(b, h) ((4 + (b) * 2 + (h)) * HTB)
#define PG8_STAGE(bufoff, gbase, voff) do { _Pragma("unroll") for (int _i = 0; _i < 2; ++_i) \
        __builtin_amdgcn_global_load_lds((const unsigned*)((const char*)(gbase) + (voff)[_i]), (PG8_LAS unsigned*)(lds + (bufoff) + ldsw + _i * 8192), 16, 0, 0); } while (0)
#define PG8_LDA(dst, b, h) do { _Pragma("unroll") for (int m = 0; m < 4; ++m) _Pragma("unroll") for (int k = 0; k < 2; ++k) dst[m][k] = *(const PG8_LAS bf16x8*)(lds + PG8_SA(b, h) + aoff + m * 2048 + k * 1024); } while (0)
#define PG8_LDB(dst, b, h) do { _Pragma("unroll") for (int n = 0; n < 2; ++n) _Pragma("unroll") for (int k = 0; k < 2; ++k) dst[n][k] = *(const PG8_LAS bf16x8*)(lds + PG8_SB(b, h) + boff + n * 2048 + k * 1024); } while (0)
#define PG8_MMA(ai, bj, At, Bt) do { __builtin_amdgcn_s_setprio(1); _Pragma("unroll") for (int m = 0; m < 4; ++m) _Pragma("unroll") for (int n = 0; n < 2; ++n) _Pragma("unroll") for (int k = 0; k < 2; ++k) \
        acc[ai][bj][m][n] = __builtin_amdgcn_mfma_f32_16x16x32_bf16(Bt[n][k], At[m][k], acc[ai][bj][m][n], 0, 0, 0); __builtin_amdgcn_s_setprio(0); } while (0)
#define PG8_WAIT_V(n) asm volatile("s_waitcnt vmcnt(" #n ")" ::: "memory")
#define PG8_WAIT_L(n) asm volatile("s_waitcnt lgkmcnt(" #n ")" ::: "memory")
#define PG8_BAR __builtin_amdgcn_s_barrier()
#define PG8_SCHED __builtin_amdgcn_sched_barrier(0)
    Unit cur, nxt; int ui = 0;
    if (!S.next(0, cur)) return;
    f32x4 acc[2][2][4][2];
#pragma unroll
    for (int a = 0; a < 2; ++a)
#pragma unroll
        for (int b = 0; b < 2; ++b)
#pragma unroll
            for (int m = 0; m < 4; ++m)
#pragma unroll
                for (int n = 0; n < 2; ++n) acc[a][b][m][n] = (f32x4){0.f, 0.f, 0.f, 0.f};
    bf16x8 At[4][2], B0[2][2], B1[2][2];
    const char* cA = (const char*)((DUAL && cur.sel) ? g.A2 : g.A) + (size_t)cur.pm * tstepA; const char* cB = (const char*)((DUAL && cur.sel) ? g.Bt2 : g.Bt) + (size_t)cur.pn * tstepB;
    S.a_ready(cur);
    if constexpr (SP2) {
        PG8_STAGE(PG8_SB(0, 0), cB, voffB); PG8_STAGE(PG8_SB(0, 1), cB + hstepB, voffB); PG8_STAGE(PG8_SA(0, 0), cA, voffA); PG8_STAGE(PG8_SA(0, 1), cA + hstepA, voffA);
        if (wr == 1) PG8_BAR;
        PG8_WAIT_V(2); PG8_BAR;
        PG8_STAGE(PG8_SB(1, 0), cB + kstep, voffB); PG8_STAGE(PG8_SA(1, 0), cA + kstep, voffA); PG8_STAGE(PG8_SB(1, 1), cB + hstepB + kstep, voffB);
        PG8_WAIT_V(6); PG8_BAR;
    } else {
        PG8_STAGE(PG8_SB(0, 0), cB, voffB); PG8_STAGE(PG8_SA(0, 0), cA, voffA); PG8_STAGE(PG8_SB(0, 1), cB + hstepB, voffB); PG8_STAGE(PG8_SA(0, 1), cA + hstepA, voffA);
        if (wr == 1) PG8_BAR;
        PG8_WAIT_V(4); PG8_BAR;
        PG8_STAGE(PG8_SB(1, 0), cB + kstep, voffB); PG8_STAGE(PG8_SA(1, 0), cA + kstep, voffA); PG8_STAGE(PG8_SB(1, 1), cB + hstepB + kstep, voffB);
        PG8_WAIT_V(6); PG8_BAR;
    }
    for (;;) {
        const bool has_next = S.next(ui + 1, nxt);
        const char* nA = has_next ? (const char*)((DUAL && nxt.sel) ? g.A2 : g.A) + (size_t)nxt.pm * tstepA : cA; const char* nB = has_next ? (const char*)((DUAL && nxt.sel) ? g.Bt2 : g.Bt) + (size_t)nxt.pn * tstepB : cB;
        for (int t = 0; t < nt; t += 2) {
            const bool last = (t == nt - 2);
            const char* a1 = cA + (size_t)(t + 1) * kstep;
            const char* a2 = last ? nA : cA + (size_t)(t + 2) * kstep; const char* b2 = last ? nB : cB + (size_t)(t + 2) * kstep;
            const char* a3 = a2 + kstep; const char* b3 = b2 + kstep;
            if (last && has_next) S.a_ready(nxt);
            if constexpr (SP2) {
            PG8_LDB(B0, 0, 0); PG8_LDB(B1, 0, 1); PG8_SCHED; PG8_LDA(At, 0, 0); PG8_STAGE(PG8_SA(1, 1), a1 + hstepA, voffA);
            PG8_WAIT_V(8); PG8_WAIT_L(0); PG8_BAR; PG8_MMA(0, 0, At, B0); PG8_MMA(0, 1, At, B1); PG8_BAR; PG8_SCHED;
            PG8_LDA(At, 0, 1); PG8_STAGE(PG8_SB(0, 0), b2, voffB); PG8_STAGE(PG8_SB(0, 1), b2 + hstepB, voffB); PG8_STAGE(PG8_SA(0, 0), a2, voffA);
            PG8_WAIT_V(8); PG8_WAIT_L(0); PG8_BAR; PG8_MMA(1, 0, At, B0); PG8_MMA(1, 1, At, B1); PG8_BAR; PG8_SCHED;
            PG8_LDB(B0, 1, 0); PG8_LDB(B1, 1, 1); PG8_SCHED; PG8_LDA(At, 1, 0); PG8_STAGE(PG8_SA(0, 1), a2 + hstepA, voffA);
            PG8_WAIT_V(8); PG8_WAIT_L(0); PG8_BAR; PG8_MMA(0, 0, At, B0); PG8_MMA(0, 1, At, B1); PG8_BAR; PG8_SCHED;
            PG8_LDA(At, 1, 1); PG8_STAGE(PG8_SB(1, 0), b3, voffB); PG8_STAGE(PG8_SB(1, 1), b3 + hstepB, voffB); PG8_STAGE(PG8_SA(1, 0), a3, voffA);
            PG8_WAIT_V(8); PG8_WAIT_L(0); PG8_BAR; PG8_MMA(1, 0, At, B0); PG8_MMA(1, 1, At, B1); PG8_BAR; PG8_SCHED;
            } else {
            PG8_LDB(B0, 0, 0); PG8_SCHED; PG8_LDA(At, 0, 0); PG8_STAGE(PG8_SA(1, 1), a1 + hstepA, voffA);
            PG8_WAIT_L(8); PG8_BAR; PG8_WAIT_L(0); PG8_MMA(0, 0, At, B0); PG8_BAR; PG8_SCHED;
            PG8_LDB(B1, 0, 1); PG8_STAGE(PG8_SB(0, 0), b2, voffB);
            PG8_BAR; PG8_WAIT_L(0); PG8_MMA(0, 1, At, B1); PG8_BAR;
            PG8_LDA(At, 0, 1); PG8_STAGE(PG8_SA(0, 0), a2, voffA);
            PG8_BAR; PG8_WAIT_L(0); PG8_MMA(1, 0, At, B0); PG8_BAR; PG8_SCHED;
            PG8_STAGE(PG8_SB(0, 1), b2 + hstepB, voffB);
            PG8_WAIT_V(6); PG8_BAR; PG8_MMA(1, 1, At, B1); PG8_BAR;
            PG8_LDB(B0, 1, 0); PG8_SCHED; PG8_LDA(At, 1, 0); PG8_STAGE(PG8_SA(0, 1), a2 + hstepA, voffA);
            PG8_WAIT_L(8); PG8_BAR; PG8_WAIT_L(0); PG8_MMA(0, 0, At, B0); PG8_BAR; PG8_SCHED;
            PG8_LDB(B1, 1, 1); PG8_STAGE(PG8_SB(1, 0), b3, voffB);
            PG8_BAR; PG8_WAIT_L(0); PG8_MMA(0, 1, At, B1); PG8_BAR;
            PG8_LDA(At, 1, 1); PG8_STAGE(PG8_SA(1, 0), a3, voffA);
            PG8_BAR; PG8_WAIT_L(0); PG8_MMA(1, 0, At, B0); PG8_BAR; PG8_SCHED;
            PG8_STAGE(PG8_SB(1, 1), b3 + hstepB, voffB);
            PG8_WAIT_V(6); PG8_BAR; PG8_MMA(1, 1, At, B1); PG8_BAR;
            }
        }
        if constexpr (ALIGN_EPI) { if (wr == 0) PG8_BAR; }
        if constexpr (DUAL) { if (cur.sel == 0) E.mid(acc, cur, wr, wc, fr, fq); else E(acc, cur, wr, wc, fr, fq); }
        else if constexpr (!Epi::AFTER_DRAIN) { E(acc, cur, wr, wc, fr, fq); S.done(cur); }
        if (!has_next) break;
        if (!(DUAL && cur.sel == 0)) {
#pragma unroll
        for (int a = 0; a < 2; ++a)
#pragma unroll
            for (int b = 0; b < 2; ++b)
#pragma unroll
                for (int m = 0; m < 4; ++m)
#pragma unroll
                    for (int n = 0; n < 2; ++n) acc[a][b][m][n] = (f32x4){0.f, 0.f, 0.f, 0.f};
        }
        cur = nxt; cA = nA; cB = nB; ++ui;
        if constexpr (ALIGN_EPI) { if (wr == 1) PG8_BAR; }
    }
    PG8_WAIT_V(0);
    if constexpr (!ALIGN_EPI) { if (wr == 0) PG8_BAR; }
    PG8_BAR;
    if constexpr (Epi::AFTER_DRAIN) { E.fused(acc, cur, wr, wc, fr, fq, lds, wid, lane); S.done(cur); }
#undef PG8_SA
#undef PG8_SB
#undef PG8_STAGE
#undef PG8_LDA
#undef PG8_LDB
#undef PG8_MMA
#undef PG8_WAIT_V
#undef PG8_WAIT_L
#undef PG8_BAR
#undef PG8_SCHED
}
}
namespace att {
using bf16 = __hip_bfloat16;
constexpr int D = 128, NW = 8, QBLK = 32, KVBLK = 64;
constexpr float SCALE = 0.088388347648318440f;
constexpr float THR = 8.f;
constexpr int LDQ = 1024, LDK = 256, LDO = 1024;
constexpr size_t SHM_V = KVBLK * D * 2, SHM_K = KVBLK * D * 2, SHM_ATTN = 3 * SHM_V + 2 * SHM_K + NW * 64 * 4;
using bf16x8 = __attribute__((ext_vector_type(8))) short;
using s16x4  = __attribute__((ext_vector_type(4))) short;
using f32x16 = __attribute__((ext_vector_type(16))) float;
using u32x4  = __attribute__((ext_vector_type(4))) unsigned;
#define KSWZ(row, colB) ((row) * 256 + ((colB) ^ (((row) & 7) << 4)))
#define SBAR() __builtin_amdgcn_sched_barrier(0)
__device__ __forceinline__ int crow(int r, int hi) { return (r & 3) + 8 * (r >> 2) + 4 * hi; }
__device__ __forceinline__ unsigned cvtpk(float lo, float hi) { unsigned r; asm volatile("v_cvt_pk_bf16_f32 %0, %1, %2" : "=v"(r) : "v"(lo), "v"(hi)); return r; }
template <bool WIN>
__device__ __forceinline__ void partialSM(f32x16& p0, f32x16& p1, float& m_reg, float& mn, float& alpha, int mb) {
  constexpr float C = SCALE * 1.4426950408889634f;
  if (WIN) {
#pragma unroll
    for (int r = 0; r < 16; ++r) { const int d0 = mb + (r & 3) + 8 * (r >> 2);
      if ((unsigned)(d0 + 128) > 256u) p0[r] = -1e30f;
      if ((unsigned)(d0 + 160) > 256u) p1[r] = -1e30f; }
  }
  float pmax = p0[0]; for (int r = 1; r < 16; ++r) pmax = fmaxf(pmax, p0[r]); for (int r = 0; r < 16; ++r) pmax = fmaxf(pmax, p1[r]);
  { auto rr = __builtin_amdgcn_permlane32_swap(__float_as_uint(pmax), __float_as_uint(pmax), false, false);
    pmax = fmaxf(__uint_as_float(rr[0]), __uint_as_float(rr[1])); }
  if (__builtin_expect(__all(pmax - m_reg <= THR / SCALE), 1)) { mn = m_reg; alpha = 1.f; }
  else { mn = fmaxf(m_reg, pmax); alpha = __builtin_amdgcn_exp2f((m_reg - mn) * C); m_reg = mn; }
  float mnC = -mn * C;
  for (int r = 0; r < 16; ++r) p0[r] = fmaf(p0[r], C, mnC); for (int r = 0; r < 16; ++r) p1[r] = fmaf(p1[r], C, mnC);
  for (int r = 0; r < 16; ++r) p0[r] = __builtin_amdgcn_exp2f(p0[r]);
}
__device__ __forceinline__ void finishSM(f32x16& p0, f32x16& p1, float alpha, float& l_reg, bf16x8& pa0, bf16x8& pa1, bf16x8& pa2, bf16x8& pa3) {
  for (int r = 0; r < 16; ++r) p1[r] = __builtin_amdgcn_exp2f(p1[r]);
  float ps = 0; for (int r = 0; r < 16; ++r) ps += p0[r]; for (int r = 0; r < 16; ++r) ps += p1[r];
  { auto rr = __builtin_amdgcn_permlane32_swap(__float_as_uint(ps), __float_as_uint(ps), false, false);
    ps = __uint_as_float(rr[0]) + __uint_as_float(rr[1]); }
  l_reg = l_reg * alpha + ps;
#define PK4(P, BASE, OUT) do { unsigned a0 = cvtpk(P[BASE + 0], P[BASE + 1]), a1 = cvtpk(P[BASE + 2], P[BASE + 3]);   \
    unsigned b0 = cvtpk(P[BASE + 4], P[BASE + 5]), b1 = cvtpk(P[BASE + 6], P[BASE + 7]);                              \
    auto r0 = __builtin_amdgcn_permlane32_swap(a0, b0, false, false); auto r1 = __builtin_amdgcn_permlane32_swap(a1, b1, false, false); \
    u32x4 w = {r0[0], r1[0], r0[1], r1[1]}; OUT = *reinterpret_cast<bf16x8*>(&w); } while (0)
  PK4(p0, 0, pa0); PK4(p0, 8, pa1); PK4(p1, 0, pa2); PK4(p1, 8, pa3);
#undef PK4
}
__device__ __forceinline__ void qkt(f32x16& p0, f32x16& p1, const bf16* Ks, const bf16x8* qr, int r32, int hi) {
  p0 = f32x16{}; p1 = f32x16{};
  for (int d0 = 0; d0 < 8; ++d0) { int cb = (d0 * 16 + hi * 8) * 2;
    bf16x8 b0 = *reinterpret_cast<const bf16x8*>((const char*)Ks + KSWZ(r32, cb));
    bf16x8 b1 = *reinterpret_cast<const bf16x8*>((const char*)Ks + KSWZ(32 + r32, cb));
    p0 = __builtin_amdgcn_mfma_f32_32x32x16_bf16(b0, qr[d0], p0, 0, 0, 0);
    p1 = __builtin_amdgcn_mfma_f32_32x32x16_bf16(b1, qr[d0], p1, 0, 0, 0); }
}
__device__ __forceinline__ int v_st(int k, int c) { const int kk = (k & ~0xC) | ((k & 4) << 1) | ((k & 8) >> 1); return ((kk >> 3) * 4 + (c >> 5)) * 512 + ((kk & 7) * 32 + (c & 31)) * 2; }
__device__ __forceinline__ int v_rd_base(int lane) { return ((lane & 3) << 3) | (((lane >> 2) & 3) << 6) | (((lane >> 4) & 1) << 5) | (((lane >> 5) & 1) << 8); }
constexpr int v_rd_off(int d0, int ks, int half) { return d0 * 512 + ks * 4096 + half * 2048; }
template <int OFF> __device__ __forceinline__ s16x4 tr_read(int vb) {
  s16x4 r; asm volatile("ds_read_b64_tr_b16 %0, %1 offset:%2" : "=&v"(r) : "v"(vb), "i"(OFF) : "memory"); return r;
}
template <int D0> __device__ __forceinline__ void pv_one(f32x16& od, int vb, bf16x8 pa0, bf16x8 pa1, bf16x8 pa2, bf16x8 pa3) {
  const s16x4 l0 = tr_read<v_rd_off(D0, 0, 0)>(vb), h0 = tr_read<v_rd_off(D0, 0, 1)>(vb), l1 = tr_read<v_rd_off(D0, 1, 0)>(vb), h1 = tr_read<v_rd_off(D0, 1, 1)>(vb);
  const s16x4 l2 = tr_read<v_rd_off(D0, 2, 0)>(vb), h2 = tr_read<v_rd_off(D0, 2, 1)>(vb), l3 = tr_read<v_rd_off(D0, 3, 0)>(vb), h3 = tr_read<v_rd_off(D0, 3, 1)>(vb);
  asm volatile("s_waitcnt lgkmcnt(0)" ::: "memory"); SBAR();
#define PK(L, H) (bf16x8){L[0], L[1], L[2], L[3], H[0], H[1], H[2], H[3]}
  od = __builtin_amdgcn_mfma_f32_32x32x16_bf16(pa0, PK(l0, h0), od, 0, 0, 0);
  od = __builtin_amdgcn_mfma_f32_32x32x16_bf16(pa1, PK(l1, h1), od, 0, 0, 0);
  od = __builtin_amdgcn_mfma_f32_32x32x16_bf16(pa2, PK(l2, h2), od, 0, 0, 0);
  od = __builtin_amdgcn_mfma_f32_32x32x16_bf16(pa3, PK(l3, h3), od, 0, 0, 0);
#undef PK
}
__device__ __forceinline__ void pv_d0(f32x16* o, int vb, bf16x8 pa0, bf16x8 pa1, bf16x8 pa2, bf16x8 pa3) {
  pv_one<0>(o[0], vb, pa0, pa1, pa2, pa3); pv_one<1>(o[1], vb, pa0, pa1, pa2, pa3); pv_one<2>(o[2], vb, pa0, pa1, pa2, pa3); pv_one<3>(o[3], vb, pa0, pa1, pa2, pa3);
}
template <bool WIN, int SDEPTH>
__device__ __forceinline__ void attn_unit(const bf16* __restrict__ Qb, const bf16* __restrict__ Kh, const bf16* __restrict__ Vh, bf16* __restrict__ Ob, int NT, char* lds, int dk0, float sink) {
  int tid_ = threadIdx.x; asm volatile("" : "+v"(tid_));
  const int tid = tid_, wid = tid >> 6, lane = tid & 63, r32 = lane & 31, hi = lane >> 5;
  bf16* V_lds = (bf16*)lds; bf16* K_lds = (bf16*)(lds + 3 * SHM_V);
  float* ws = (float*)(lds + 3 * SHM_V + 2 * SHM_K) + wid * 64; float* li_l = ws; float* al_l = ws + 32;
  float m_reg = WIN ? sink * (1.0f / SCALE) : -1e30f, l_reg = WIN ? 1.f : 0.f; f32x16 o[4] = {}; bf16x8 qr[8];
  const int mb0 = dk0 + 4 * hi - (wid * QBLK + r32);
  const bf16* Qw = Qb + (long)(wid * QBLK + r32) * LDQ + hi * 8;
#pragma unroll
  for (int d0 = 0; d0 < 8; ++d0) qr[d0] = *reinterpret_cast<const bf16x8*>(Qw + d0 * 16);
  const int sr = tid >> 4, sc = (tid & 15) * 8, vst0 = v_st(sr, sc), vst1 = v_st(32 + sr, sc);
  const int vb0 = (int)(uintptr_t)V_lds + v_rd_base(lane);
  struct { bf16x8 vs0, vs1, ks0, ks1; } sr_[SDEPTH];
#define SLOAD(i, k0) do { sr_[i].vs0 = *reinterpret_cast<const bf16x8*>(&Vh[(long)((k0) + sr) * LDK + sc]); sr_[i].vs1 = *reinterpret_cast<const bf16x8*>(&Vh[(long)((k0) + 32 + sr) * LDK + sc]); \
    sr_[i].ks0 = *reinterpret_cast<const bf16x8*>(&Kh[(long)((k0) + sr) * LDK + sc]); sr_[i].ks1 = *reinterpret_cast<const bf16x8*>(&Kh[(long)((k0) + 32 + sr) * LDK + sc]); } while (0)
#define SWRITE2(b, i, vs) do { *(bf16x8*)((char*)V_lds + (vs) * SHM_V + vst0) = sr_[i].vs0;          \
    *(bf16x8*)((char*)V_lds + (vs) * SHM_V + vst1) = sr_[i].vs1; int kc = sc * 2;               \
    *(bf16x8*)((char*)K_lds + (b) * SHM_K + KSWZ(sr, kc)) = sr_[i].ks0;                       \
    *(bf16x8*)((char*)K_lds + (b) * SHM_K + KSWZ(32 + sr, kc)) = sr_[i].ks1; } while (0)
#define SWRITE(b, i) SWRITE2(b, i, b)
#define SWAIT() do { if constexpr (SDEPTH == 2) asm volatile("s_waitcnt vmcnt(4)" ::: "memory"); else asm volatile("s_waitcnt vmcnt(0)" ::: "memory"); } while (0)
#define RESC(a) do { if (__any((a) < 1.f)) { if (hi == 0) al_l[r32] = (a); asm volatile("s_waitcnt lgkmcnt(0)" ::: "memory"); \
    for (int d = 0; d < 4; ++d) for (int r = 0; r < 16; ++r) o[d][r] *= al_l[crow(r, hi)]; } } while (0)
  f32x16 pA0, pA1, pB0, pB1; float mnA, mnB, alA, alB; bf16x8 pa0, pa1, pa2, pa3;
  const int wq = __builtin_amdgcn_readfirstlane(wid) * QBLK;
#define NEED(j) (!WIN || ((64 * (j) + dk0 + 63 >= wq - 128) && (64 * (j) + dk0 <= wq + QBLK - 1 + 128)))
#define QKT(P0, P1, Ks, j) do { if (NEED(j)) qkt(P0, P1, Ks, qr, r32, hi); else { _Pragma("unroll") for (int r_ = 0; r_ < 16; ++r_) { P0[r_] = -1e30f; P1[r_] = -1e30f; } } } while (0)
#define PV(vb, j) do { if (NEED(j)) pv_d0(o, vb, pa0, pa1, pa2, pa3); } while (0)
  constexpr int SE = 0, SO = SDEPTH - 1;
  SLOAD(SE, 0); asm volatile("s_waitcnt vmcnt(0)" ::: "memory"); SWRITE(0, SE); __syncthreads();
  QKT(pA0, pA1, K_lds, 0); partialSM<WIN>(pA0, pA1, m_reg, mnA, alA, mb0);
  SLOAD(SO, KVBLK); if constexpr (SDEPTH == 2) { if (2 < NT) SLOAD(SE, 2 * KVBLK); }
  SWAIT(); SWRITE(1, SO); __syncthreads();
#define HSTEP(PN0, PN1, MNN, ALN, PO0, PO1, ALO, KB, VRD, VWR, t) do { \
    SBAR(); SLOAD(SE, ((t) + 1) * KVBLK); SBAR(); \
    QKT(PN0, PN1, (bf16*)((char*)K_lds + (KB) * SHM_K), t); \
    finishSM(PO0, PO1, ALO, l_reg, pa0, pa1, pa2, pa3); SBAR(); \
    PV(vb0 + (VRD) * (int)SHM_V, (t) - 1); partialSM<WIN>(PN0, PN1, m_reg, MNN, ALN, mb0 + 64 * (t)); \
    SWAIT(); SWRITE2((KB) ^ 1, SE, VWR); \
    RESC(ALN); __syncthreads(); } while (0)
  if constexpr (!WIN && SDEPTH == 1) {
    for (int j = 1; j + 1 < NT; j += 6) {
      HSTEP(pB0, pB1, mnB, alB, pA0, pA1, alA, 1, 0, 2, j);
      HSTEP(pA0, pA1, mnA, alA, pB0, pB1, alB, 0, 1, 0, j + 1);
      HSTEP(pB0, pB1, mnB, alB, pA0, pA1, alA, 1, 2, 1, j + 2);
      HSTEP(pA0, pA1, mnA, alA, pB0, pB1, alB, 0, 0, 2, j + 3);
      HSTEP(pB0, pB1, mnB, alB, pA0, pA1, alA, 1, 1, 0, j + 4);
      HSTEP(pA0, pA1, mnA, alA, pB0, pB1, alB, 0, 2, 1, j + 5);
    }
    SBAR(); QKT(pB0, pB1, (bf16*)((char*)K_lds + SHM_K), NT - 1);
    finishSM(pA0, pA1, alA, l_reg, pa0, pa1, pa2, pa3); SBAR();
    PV(vb0, NT - 2); partialSM<WIN>(pB0, pB1, m_reg, mnB, alB, mb0 + 64 * (NT - 1));
    RESC(alB);
    finishSM(pB0, pB1, alB, l_reg, pa0, pa1, pa2, pa3); SBAR();
    PV(vb0 + (int)SHM_V, NT - 1);
  } else {
  for (int j = 1; j + 1 < NT; j += 2) {
    SBAR(); QKT(pB0, pB1, (bf16*)((char*)K_lds + SHM_K), j);
    finishSM(pA0, pA1, alA, l_reg, pa0, pa1, pa2, pa3); SBAR();
    SLOAD(SO, (j + SDEPTH) * KVBLK); SBAR();
    PV(vb0, j - 1); partialSM<WIN>(pB0, pB1, m_reg, mnB, alB, mb0 + 64 * j);
    __syncthreads(); SWAIT(); SWRITE(0, SE);
    RESC(alB); __syncthreads();
    SBAR(); QKT(pA0, pA1, K_lds, j + 1);
    finishSM(pB0, pB1, alB, l_reg, pa0, pa1, pa2, pa3); SBAR();
    if (SDEPTH == 1 || j + 3 < NT) SLOAD(SE, (j + 1 + SDEPTH) * KVBLK); SBAR();
    PV(vb0 + (int)SHM_V, j); partialSM<WIN>(pA0, pA1, m_reg, mnA, alA, mb0 + 64 * (j + 1));
    __syncthreads(); SWAIT(); SWRITE(1, SO);
    RESC(alA); __syncthreads();
  }
  SBAR(); QKT(pB0, pB1, (bf16*)((char*)K_lds + SHM_K), NT - 1);
  finishSM(pA0, pA1, alA, l_reg, pa0, pa1, pa2, pa3); SBAR();
  PV(vb0, NT - 2); partialSM<WIN>(pB0, pB1, m_reg, mnB, alB, mb0 + 64 * (NT - 1));
  __syncthreads(); RESC(alB);
  finishSM(pB0, pB1, alB, l_reg, pa0, pa1, pa2, pa3); SBAR();
  PV(vb0 + (int)SHM_V, NT - 1);
  }
  if (hi == 0) li_l[r32] = l_reg; asm volatile("s_waitcnt lgkmcnt(0)" ::: "memory");
  float rli[16];
#pragma unroll
  for (int r = 0; r < 16; ++r) rli[r] = __builtin_amdgcn_rcpf(li_l[crow(r, hi)]);
  bf16* Ow = Ob + (long)(wid * QBLK) * LDO;
#pragma unroll
  for (int r = 0; r < 16; ++r) { int orow = crow(r, hi);
    for (int d0 = 0; d0 < 4; ++d0) Ow[(long)orow * LDO + d0 * 32 + r32] = __float2bfloat16(o[d0][r] * rli[r]); }
  asm volatile("s_waitcnt lgkmcnt(0)" ::: "memory"); __syncthreads();
#undef HSTEP
#undef SWRITE2
#undef NEED
#undef QKT
#undef PV
#undef SLOAD
#undef SWRITE
#undef SWAIT
#undef RESC
}
#undef KSWZ
#undef SBAR
}

#ifndef SD_DENSE
#define SD_DENSE 2
#endif
#ifndef SD_WIN
#define SD_WIN 1
#endif
#ifndef WGM_P1
#define WGM_P1 4
#endif
#ifndef WGM_P3
#define WGM_P3 4
#endif
#ifndef WGM_P3C
#define WGM_P3C 4
#endif
#ifndef WGM_P4
#define WGM_P4 4
#endif
#ifndef WGM_P5
#define WGM_P5 4
#endif
#ifndef ROWS_P0
#define ROWS_P0 2
#endif
#ifndef ROWS_P6
#define ROWS_P6 2
#endif
#ifndef REP_PHASE
#define REP_PHASE -1
#endif
#define LAS __attribute__((address_space(3)))
typedef unsigned short bf16r;
typedef unsigned v4u __attribute__((ext_vector_type(4)));
typedef unsigned v2u __attribute__((ext_vector_type(2)));
typedef float v4f __attribute__((ext_vector_type(4)));
constexpr int NWAVES = 8;
__device__ __forceinline__ unsigned f2bf(float f) { unsigned u = __builtin_bit_cast(unsigned, f); return (u + 0x7fffu + ((u >> 16) & 1u)) >> 16; }
__device__ __forceinline__ unsigned pk2(float lo, float hi) { return f2bf(lo) | (f2bf(hi) << 16); }
__device__ __forceinline__ float wave_sum(float v) {
#pragma unroll
    for (int o = 1; o < 64; o <<= 1) v += __shfl_xor(v, o);
    return v;
}
__device__ __forceinline__ int map_win(int c) {
    if (c < 1280) { const int d = c & 127; const int p = 32 * (2 * (d >> 6) + ((d >> 4) & 1)) + 8 * ((d >> 2) & 3) + 4 * ((d >> 5) & 1) + (d & 3); return (c & ~127) + p; }
    if (c >= 1536 && c < 2816) { const int d = c & 127; const int p = 32 * ((d >> 4) & 3) + 8 * ((d >> 2) & 3) + 4 * (d >> 6) + (d & 3); return (c & ~127) + p; }
    return c;
}
__device__ __forceinline__ int map_wup(int c) { return c < DFF ? ((c >> 7) * 256 + (c & 127)) : (((c - DFF) >> 7) * 256 + 128 + ((c - DFF) & 127)); }
template <int MAP>
__device__ __forceinline__ void transpose_item(const float* W, int K, int N, bf16r* WT, LAS float* scr, int item, int lane) {
    const int nblk = N / 32, kb = item / nblk, nb = item % nblk, k0 = 64 * kb, n0 = 32 * nb;
#pragma unroll 8
    for (int i = 0; i < 32; ++i) { const int kk = 2 * i + (lane >> 5); scr[kk * 33 + (lane & 31)] = __builtin_nontemporal_load(W + (size_t)(k0 + kk) * N + n0 + (lane & 31)); }
    asm volatile("s_waitcnt lgkmcnt(0)" ::: "memory");
    const int c = lane & 7;
#pragma unroll
    for (int j = 0; j < 4; ++j) { const int n = (lane >> 3) + 8 * j; const LAS float* s = scr + (8 * c) * 33 + n;
        v4u o; o.x = pk2(s[0 * 33], s[1 * 33]); o.y = pk2(s[2 * 33], s[3 * 33]); o.z = pk2(s[4 * 33], s[5 * 33]); o.w = pk2(s[6 * 33], s[7 * 33]);
        const int src = n0 + n; const int dst = MAP == 1 ? map_win(src) : (MAP == 2 ? map_wup(src) : src);
        *(v4u*)(WT + (size_t)dst * K + k0 + 8 * c) = o; }
    asm volatile("s_waitcnt lgkmcnt(0)" ::: "memory");
}
__device__ __forceinline__ const float* xrow_ptr(const float* xp, const float* xs, int tok) { return tok < NPROMPT ? xp + (size_t)tok * DM : xs + (size_t)(tok - NPROMPT) * DM; }

#define XB_TMO      128
#define XB_XCNT(j)  (256  + 64 * (j))
#define XB_XSUB(j)  (1280 + 64 * (j))
#define XB_XGEN(j)  (2304 + 64 * (j))
#define XB_TOP      3328
#define XB_TOPGEN   3392
#define XCD_BAR_WORDS 3456
#define XB_SPIN_CAP (1u << 22)

__device__ __forceinline__ unsigned xb_ld(unsigned* p)              { return __hip_atomic_load(p, __ATOMIC_RELAXED, __HIP_MEMORY_SCOPE_AGENT); }
__device__ __forceinline__ unsigned xb_add(unsigned* p, unsigned v) { return __hip_atomic_fetch_add(p, v, __ATOMIC_RELAXED, __HIP_MEMORY_SCOPE_AGENT); }
__device__ __forceinline__ unsigned xb_xcc_id() { return (unsigned)__builtin_amdgcn_s_getreg((3 << 11) | 20) & 0xFu; }
#define XB_SPIN(cond, bar) do { unsigned _sp = 0; while (cond) { __builtin_amdgcn_s_sleep(1); \
    if ((++_sp & 255u) == 0u) { if (xb_ld(&(bar)[XB_TMO])) break; if (_sp > XB_SPIN_CAP) { atomicAdd(&(bar)[XB_TMO], 1u); break; } } } } while (0)

struct XcdBarrier {
    unsigned* bar; unsigned x;
    volatile LAS unsigned* st;
};

__device__ __forceinline__ XcdBarrier xcd_barrier_post(unsigned* bar, volatile LAS unsigned* st) {
    XcdBarrier b; b.bar = bar; b.x = xb_xcc_id(); b.st = st;
    if (threadIdx.x == 0) (void)xb_add(&bar[XB_XCNT(b.x)], 1u);
    return b;
}
__device__ __forceinline__ void xcd_barrier_complete(unsigned* bar, unsigned x, unsigned& nloc, unsigned& nx) {
    const unsigned G = gridDim.x * gridDim.y * gridDim.z;
    unsigned sum, cnt, mine, sp = 0u;
    for (;;) {
        sum = 0u; cnt = 0u; mine = 0u;
#pragma unroll
        for (unsigned j = 0; j < 16; ++j) { const unsigned c = xb_ld(&bar[XB_XCNT(j)]); sum += c; cnt += (c > 0u) ? 1u : 0u; mine = (j == x) ? c : mine; }
        if (sum == G) break;
        __builtin_amdgcn_s_sleep(1);
        if ((++sp & 255u) == 0u) { if (xb_ld(&bar[XB_TMO])) break; if (sp > XB_SPIN_CAP) { atomicAdd(&bar[XB_TMO], 1u); break; } }
    }
    nloc = mine > 0u ? mine : 1u; nx = cnt > 0u ? cnt : 1u;
}

__device__ __forceinline__ void xcd_barrier(const XcdBarrier& b) {
    asm volatile("s_waitcnt vmcnt(0)" ::: "memory");
    __syncthreads();
    if (threadIdx.x == 0) {
        unsigned* bar = b.bar;
        __builtin_amdgcn_s_waitcnt(0);
        unsigned nloc = b.st[0], nx = b.st[1];
        if (nloc == 0u) { xcd_barrier_complete(bar, b.x, nloc, nx); b.st[0] = nloc; b.st[1] = nx; }
        const unsigned old = xb_add(&bar[XB_XSUB(b.x)], 1u);
        const unsigned gen = old / nloc;
        if (old + 1u == (gen + 1u) * nloc) {
            __builtin_amdgcn_fence(__ATOMIC_RELEASE, "agent");
            asm volatile("s_waitcnt vmcnt(0)" ::: "memory");
            const unsigned og = xb_add(&bar[XB_TOP], 1u);
            const unsigned tg = og / nx;
            if (og + 1u == (tg + 1u) * nx) xb_add(&bar[XB_TOPGEN], 1u);
            else XB_SPIN(xb_ld(&bar[XB_TOPGEN]) == tg, bar);
            __builtin_amdgcn_fence(__ATOMIC_ACQUIRE, "agent");
            xb_add(&bar[XB_XGEN(b.x)], 1u);
            asm volatile("s_waitcnt vmcnt(0)" ::: "memory");
        } else {
            XB_SPIN(xb_ld(&bar[XB_XGEN(b.x)]) == gen, bar);
            __builtin_amdgcn_fence(__ATOMIC_ACQUIRE, "agent");
            asm volatile("s_waitcnt vmcnt(0)" ::: "memory");
        }
    }
    __syncthreads();
}

struct Args { const float* in[17]; float* out; unsigned char* ws; double invf_t[64]; double invf_ax[32]; };

__global__ void __launch_bounds__(NWAVES * 64, 2) mega_fwd(Args args) {
    extern __shared__ __attribute__((aligned(16))) unsigned char lds[];
    cg::grid_group grid = cg::this_grid();
    const int tid = threadIdx.x, lane = tid & 63, wave = __builtin_amdgcn_readfirstlane(tid >> 6);
    const int G = gridDim.x, bx = blockIdx.x;
    const int vcu = (G % 8 == 0) ? (bx % 8) * (G / 8) + bx / 8 : bx;
    const int gw = vcu * NWAVES + wave, NGW = G * NWAVES;
    unsigned char* ws = args.ws;
    const float* x_prompt = args.in[0]; const float* x_sample = args.in[1];
    const float* norm_pre_mix = args.in[2]; const float* w_in = args.in[3]; const float* q_norm_a = args.in[4]; const float* k_norm_a = args.in[5];
    const float* sink_b = args.in[6]; const float* w_branch_a = args.in[7]; const float* w_branch_b = args.in[8]; const float* w_out = args.in[9];
    const float* norm_post_mix = args.in[10]; const float* norm_pre_ffn = args.in[11]; const float* w_up = args.in[12]; const float* conv_w = args.in[13];
    const float* conv_b = args.in[14]; const float* w_down = args.in[15]; const float* norm_post_ffn = args.in[16];
    float* out = args.out;
    bf16r* WinT = (bf16r*)(ws + WS_WIN); bf16r* WaT = (bf16r*)(ws + WS_WA); bf16r* WbT = (bf16r*)(ws + WS_WB); bf16r* WoutT = (bf16r*)(ws + WS_WOUT);
    bf16r* WupT = (bf16r*)(ws + WS_WUP); bf16r* WdownT = (bf16r*)(ws + WS_WDOWN);
    bf16r* Hb = (bf16r*)(ws + WS_H);

    unsigned* barw = (unsigned*)(ws + 65536);
    volatile LAS unsigned* bar_st = (volatile LAS unsigned*)((LAS unsigned char*)lds + 143360);
    if (bx == 0) for (int i = tid; i < XCD_BAR_WORDS; i += NWAVES * 64) barw[i] = 0u;
    if (tid < 2) bar_st[tid] = 0u;
    XcdBarrier xbar;
#define GRID_BAR() xcd_barrier(xbar)
#ifndef SKIP_0
    for (int rep_ = 0; rep_ < (REP_PHASE == 0 ? 2 : 1); ++rep_) {
        LAS float* scr = (LAS float*)((LAS unsigned char*)lds + wave * 16384);
        constexpr int I_IN = (DM / 64) * (NIN / 32), I_A = (1024 / 64) * (DM / 32), I_OUT = (DM / 64) * (DM / 32), I_UP = (DM / 64) * (NUP / 32), I_DN = (DFF / 64) * (DM / 32);
        constexpr int NITEMS = I_IN + 2 * I_A + I_OUT + I_UP + I_DN;
        for (int it = gw; it < NITEMS; it += NGW) {
            int r = it;
            if (r < I_IN) { transpose_item<1>(w_in, DM, NIN, WinT, scr, r, lane); continue; } r -= I_IN;
            if (r < I_A) { transpose_item<0>(w_branch_a, 1024, DM, WaT, scr, r, lane); continue; } r -= I_A;
            if (r < I_A) { transpose_item<0>(w_branch_b, 1024, DM, WbT, scr, r, lane); continue; } r -= I_A;
            if (r < I_OUT) { transpose_item<0>(w_out, DM, DM, WoutT, scr, r, lane); continue; } r -= I_OUT;
            if (r < I_UP) { transpose_item<2>(w_up, DM, NUP, WupT, scr, r, lane); continue; } r -= I_UP;
            transpose_item<0>(w_down, DFF, DM, WdownT, scr, r, lane);
        }
        float* cost = (float*)(ws + WS_COST); float* sint = (float*)(ws + WS_SINT); float* ax = (float*)(ws + WS_AX);
        for (int e = vcu * 512 + tid; e < 8192 * 64; e += G * 512) { const int t = e >> 6, i = e & 63; double a = (double)t * args.invf_t[i]; a -= floor(a); const float fr = (float)a;
            cost[e] = __builtin_amdgcn_cosf(fr); sint[e] = __builtin_amdgcn_sinf(fr); }
        for (int e = vcu * 512 + tid; e < 128 * 32 + 64 * 32; e += G * 512) {
            const bool isrow = e < 128 * 32; const int e2 = isrow ? e : e - 128 * 32; const int pos = e2 >> 5, i = e2 & 31;
            double a = (double)pos * args.invf_ax[i]; a -= floor(a); const float fr = (float)a;
            const float c = __builtin_amdgcn_cosf(fr), s = __builtin_amdgcn_sinf(fr);
            if (isrow) { ax[e2] = c; ax[4096 + e2] = s; } else { ax[8192 + e2] = c; ax[10240 + e2] = s; } }
        for (int e = vcu * 512 + tid; e < NPAD; e += G * 512) ((int*)(ws + WS_TOKMAP))[e] = pg8::conv_row_token(e);
        for (int m0 = gw; m0 < NTOK; m0 += ROWS_P0 * NGW) {
            v4f v[ROWS_P0][8];
#pragma unroll
            for (int r = 0; r < ROWS_P0; ++r) { const int m = m0 + r * NGW; if (m < NTOK) { const v4f* xr = (const v4f*)xrow_ptr(x_prompt, x_sample, m) + lane;
#pragma unroll
                for (int j = 0; j < 8; ++j) v[r][j] = __builtin_nontemporal_load(xr + 64 * j); } }
#pragma unroll
            for (int r = 0; r < ROWS_P0; ++r) { const int m = m0 + r * NGW; if (m >= NTOK) continue;
                float s = 0.f;
#pragma unroll
                for (int j = 0; j < 8; ++j) s += (v[r][j].x * v[r][j].x + v[r][j].y * v[r][j].y) + (v[r][j].z * v[r][j].z + v[r][j].w * v[r][j].w);
                const float rstd = 1.f / sqrtf(wave_sum(s) * (1.f / DM) + RMS_EPS);
                unsigned long long* o8 = (unsigned long long*)(Hb + (size_t)m * DM) + lane;
#pragma unroll
                for (int j = 0; j < 8; ++j) { const v4f g = *((const v4f*)norm_pre_mix + lane + 64 * j);
                    o8[64 * j] = (unsigned long long)pk2(v[r][j].x * rstd * g.x, v[r][j].y * rstd * g.y) | ((unsigned long long)pk2(v[r][j].z * rstd * g.z, v[r][j].w * rstd * g.w) << 32); } }
        }
    }
#endif
    grid.sync();
    xbar = xcd_barrier_post(barw, bar_st);

#ifdef EXTRA_SYNCS
    for (int q_ = 0; q_ < EXTRA_SYNCS; ++q_) grid.sync();
#endif
#ifndef SKIP_1
    for (int rep_ = 0; rep_ < (REP_PHASE == 1 ? 2 : 1); ++rep_) {
        pg8::Gemm g{Hb, WinT, NTOK, NIN, DM, nullptr, nullptr}; pg8::StaticOrder S; S.init(NTOK, NIN, G, bx, WGM_P1);
        pg8::EpiProj E{ws, q_norm_a, k_norm_a, (LAS float*)((LAS unsigned char*)lds + 131072)};
        pg8::gemm_phase<pg8::EpiProj, pg8::StaticOrder, true, true, false>((LAS unsigned char*)lds, g, S, E);
    }
#endif
    GRID_BAR();

#ifndef SKIP_3
    for (int rep_ = 0; rep_ < (REP_PHASE == 3 ? 2 : 1); ++rep_) {
        using abf = att::bf16;
        const abf* qA = (const abf*)(ws + WS_QA); const abf* kA = (const abf*)(ws + WS_KA); const abf* vA = (const abf*)(ws + WS_VA);
        const abf* qB = (const abf*)(ws + WS_QB); const abf* kB = (const abf*)(ws + WS_KB); const abf* vB = (const abf*)(ws + WS_VB);
        abf* oA = (abf*)(ws + WS_OA); abf* oB = (abf*)(ws + WS_OB);
#ifndef SKIP_DP
        for (int i = 0; i < 6; ++i) {
            size_t tok0, kr; int h, NT;
            if (i < 4) { const int u = vcu * 4 + i; const int bh = u >> 5, qb = u & 31, b = bh >> 3; h = bh & 7; kr = (size_t)b * 8192; tok0 = kr + qb * 256; NT = 128; }
            else { const int u = vcu * 2 + (i - 4); const int bh = u >> 3, qb = u & 7, b = bh >> 3; h = bh & 7; kr = (size_t)NPROMPT + (size_t)b * 2048; tok0 = kr + qb * 256; NT = 32; }
            att::attn_unit<false, SD_DENSE>(qA + tok0 * 1024 + h * 128, kA + kr * 256 + (h >> 2) * 128, vA + kr * 256 + (h >> 2) * 128, oA + tok0 * 1024 + h * 128, NT, (char*)lds, 0, 0.f); }
        for (int i = 0; i < 6; ++i) {
            const int u = vcu * 6 + i; const int tb = u >> 3, h = u & 7; const int t0 = tb * 256; int sbase, SL;
            if (t0 < NPROMPT) { sbase = t0 & ~8191; SL = 8192; } else { sbase = NPROMPT + ((t0 - NPROMPT) & ~2047); SL = 2048; }
            const int q0 = t0 - sbase; const int kt0 = q0 >= 128 ? q0 - 128 : 0; const int kt1 = (q0 + 384 <= SL) ? q0 + 384 : SL; const int NT = (kt1 - kt0) >> 6;
            const size_t kr = (size_t)sbase + kt0, tok0 = (size_t)t0;
            att::attn_unit<true, SD_WIN>(qB + tok0 * 1024 + h * 128, kB + kr * 256 + (h >> 2) * 128, vB + kr * 256 + (h >> 2) * 128, oB + tok0 * 1024 + h * 128, NT, (char*)lds, kt0 - q0, sink_b[h]); }
#endif
        __syncthreads();
    }
#endif
    GRID_BAR();

#ifndef SKIP_4
    for (int rep_ = 0; rep_ < (REP_PHASE == 4 ? 2 : 1); ++rep_) {
        pg8::PairOrder S; S.base.init(NTOK, DM, G, bx, WGM_P3);
        pg8::Gemm g{(const bf16r*)(ws + WS_OA), WaT, NTOK, DM, 1024, (const bf16r*)(ws + WS_OB), WbT};
        pg8::EpiGate2 E{(const bf16r*)(ws + WS_GA), (const bf16r*)(ws + WS_GB), (bf16r*)(ws + WS_MERGED)};
        pg8::gemm_phase<pg8::EpiGate2, pg8::PairOrder, true, true, false, true>((LAS unsigned char*)lds, g, S, E);
    }
#endif
    GRID_BAR();

#ifndef SKIP_5
    for (int rep_ = 0; rep_ < (REP_PHASE == 5 ? 2 : 1); ++rep_) {
        pg8::Gemm g{(const bf16r*)(ws + WS_MERGED), WoutT, NTOK, DM, DM, nullptr, nullptr}; pg8::StaticOrder S; S.init(NTOK, DM, G, bx, WGM_P3C);
        pg8::EpiBf16Plain E{(bf16r*)(ws + WS_MIX)};
        pg8::gemm_phase<pg8::EpiBf16Plain, pg8::StaticOrder, true, true, false>((LAS unsigned char*)lds, g, S, E);
    }
#endif
    GRID_BAR();

#ifndef SKIP_6
    {
        int lnL = lane; asm volatile("" : "+v"(lnL));
        for (int P0 = gw; P0 < NPAD; P0 += 2 * NGW) {
            v4f mv[2][8], xv[2][8]; int tokr[2]; bool istok[2];
#pragma unroll
            for (int r = 0; r < 2; ++r) { const int P = P0 + r * NGW; istok[r] = false; tokr[r] = 0;
                if (P < NPAD) { const int tk = ((const int*)(ws + WS_TOKMAP))[P];
                    if (tk >= 0) { istok[r] = true; tokr[r] = tk;
                        const v2u* mrow = (const v2u*)((const bf16r*)(ws + WS_MIX) + (size_t)tokr[r] * DM) + lnL; const v4f* xr = (const v4f*)xrow_ptr(x_prompt, x_sample, tokr[r]) + lnL;
#pragma unroll
                        for (int j = 0; j < 8; ++j) { const v2u w = __builtin_nontemporal_load(mrow + 64 * j); mv[r][j] = (v4f){pg8::bf_lo(w.x), pg8::bf_hi(w.x), pg8::bf_lo(w.y), pg8::bf_hi(w.y)}; xv[r][j] = __builtin_nontemporal_load(xr + 64 * j); } } } }
#pragma unroll
            for (int r = 0; r < 2; ++r) { const int P = P0 + r * NGW; if (P >= NPAD) continue;
                unsigned long long* o8 = (unsigned long long*)(Hb + (size_t)P * DM) + lnL;
                if (!istok[r]) {
#pragma unroll
                    for (int j = 0; j < 8; ++j) o8[64 * j] = 0ull;
                    continue; }
                unsigned long long* x1row = (unsigned long long*)(tokr[r] < X1_SPLIT ? ws + WS_X1A + (size_t)tokr[r] * (DM * 2) : ws + WS_X1B + (size_t)(tokr[r] - X1_SPLIT) * (DM * 2)) + lnL;
                float s = 0.f;
#pragma unroll
                for (int j = 0; j < 8; ++j) s += (mv[r][j].x * mv[r][j].x + mv[r][j].y * mv[r][j].y) + (mv[r][j].z * mv[r][j].z + mv[r][j].w * mv[r][j].w);
                const float rstd = 1.f / sqrtf(wave_sum(s) * (1.f / DM) + RMS_EPS);
                float s2 = 0.f;
#pragma unroll
                for (int j = 0; j < 8; ++j) { const v4f g = *((const v4f*)norm_post_mix + lnL + 64 * j); const v4f x1 = xv[r][j] + mv[r][j] * rstd * g; mv[r][j] = x1; __builtin_nontemporal_store((unsigned long long)pk2(x1.x, x1.y) | ((unsigned long long)pk2(x1.z, x1.w) << 32), x1row + 64 * j);
                    s2 += (x1.x * x1.x + x1.y * x1.y) + (x1.z * x1.z + x1.w * x1.w); }
                const float rstd2 = 1.f / sqrtf(wave_sum(s2) * (1.f / DM) + RMS_EPS);
#pragma unroll
                for (int j = 0; j < 8; ++j) { const v4f g = *((const v4f*)norm_pre_ffn + lnL + 64 * j); const v4f x1 = mv[r][j];
                    o8[64 * j] = (unsigned long long)pk2(x1.x * rstd2 * g.x, x1.y * rstd2 * g.y) | ((unsigned long long)pk2(x1.z * rstd2 * g.z, x1.w * rstd2 * g.w) << 32); } }
        }
    }
#endif
    GRID_BAR();

#ifndef SKIP_7
    for (int rep_ = 0; rep_ < (REP_PHASE == 7 ? 2 : 1); ++rep_) {
        pg8::Gemm g{Hb, WupT, MT_UP * 256, NUP, DM, nullptr, nullptr}; pg8::StaticOrder S; S.init(MT_UP * 256, NUP, G, bx, WGM_P4);
        pg8::EpiConv E{conv_w, conv_b, (bf16r*)(ws + WS_ACT), (const int*)(ws + WS_TOKMAP)};
        pg8::gemm_phase<pg8::EpiConv, pg8::StaticOrder, P4_ALIGN, true, true>((LAS unsigned char*)lds, g, S, E);
    }
#endif
    GRID_BAR();

#ifndef SKIP_8
    for (int rep_ = 0; rep_ < (REP_PHASE == 8 ? 2 : 1); ++rep_) {
        pg8::Gemm g{(const bf16r*)(ws + WS_ACT), WdownT, NTOK, DM, DFF, nullptr, nullptr}; pg8::StaticOrder S; S.init(NTOK, DM, G, bx, WGM_P5);
        pg8::EpiBf16Plain E{Hb};
        pg8::gemm_phase<pg8::EpiBf16Plain, pg8::StaticOrder, true, true, false>((LAS unsigned char*)lds, g, S, E);
    }
#endif
    GRID_BAR();

#ifndef SKIP_9
    {
        int lnL = lane; asm volatile("" : "+v"(lnL));
        for (int m0 = gw; m0 < NTOK; m0 += ROWS_P6 * NGW) {
            v4u fw[ROWS_P6][4]; v4u xw[ROWS_P6][4];
#pragma unroll
            for (int r = 0; r < ROWS_P6; ++r) { const int m = m0 + r * NGW; if (m < NTOK) { const v4u* fr_ = (const v4u*)(Hb + (size_t)m * DM) + lnL; const v4u* xr_ = (const v4u*)(m < X1_SPLIT ? ws + WS_X1A + (size_t)m * (DM * 2) : ws + WS_X1B + (size_t)(m - X1_SPLIT) * (DM * 2)) + lnL;
#pragma unroll
                for (int c = 0; c < 4; ++c) { fw[r][c] = __builtin_nontemporal_load(fr_ + 64 * c); xw[r][c] = __builtin_nontemporal_load(xr_ + 64 * c); } } }
#pragma unroll
            for (int r = 0; r < ROWS_P6; ++r) { const int m = m0 + r * NGW; if (m >= NTOK) continue;
                float f[4][8]; float s = 0.f;
#pragma unroll
                for (int c = 0; c < 4; ++c) { const v4u w = fw[r][c];
                    f[c][0] = pg8::bf_lo(w.x); f[c][1] = pg8::bf_hi(w.x); f[c][2] = pg8::bf_lo(w.y); f[c][3] = pg8::bf_hi(w.y); f[c][4] = pg8::bf_lo(w.z); f[c][5] = pg8::bf_hi(w.z); f[c][6] = pg8::bf_lo(w.w); f[c][7] = pg8::bf_hi(w.w);
#pragma unroll
                    for (int e = 0; e < 8; ++e) s += f[c][e] * f[c][e]; }
                const float rstd = 1.f / sqrtf(wave_sum(s) * (1.f / DM) + RMS_EPS);
                float* orow = out + (size_t)m * DM;
#pragma unroll
                for (int c = 0; c < 4; ++c) { const int e0 = 8 * lnL + 512 * c;
                    const v4f g0 = *(const v4f*)(norm_post_ffn + e0), g1 = *(const v4f*)(norm_post_ffn + e0 + 4);
                    const v4u xq = xw[r][c]; v4f a0 = {pg8::bf_lo(xq.x), pg8::bf_hi(xq.x), pg8::bf_lo(xq.y), pg8::bf_hi(xq.y)}, a1 = {pg8::bf_lo(xq.z), pg8::bf_hi(xq.z), pg8::bf_lo(xq.w), pg8::bf_hi(xq.w)};
                    a0.x += f[c][0] * rstd * g0.x; a0.y += f[c][1] * rstd * g0.y; a0.z += f[c][2] * rstd * g0.z; a0.w += f[c][3] * rstd * g0.w;
                    a1.x += f[c][4] * rstd * g1.x; a1.y += f[c][5] * rstd * g1.y; a1.z += f[c][6] * rstd * g1.z; a1.w += f[c][7] * rstd * g1.w;
                    __builtin_nontemporal_store(a0, (v4f*)(orow + e0)); __builtin_nontemporal_store(a1, (v4f*)(orow + e0 + 4)); } }
        }
    }
#endif
}

extern "C" void kernel_launch(void* const* d_in, const int* in_sizes, int n_in, void* d_out, int out_size, void* d_ws, size_t ws_size, hipStream_t stream) {
    static int grid = 0;
    if (grid == 0) {
        if (n_in != 17 || ws_size < WS_END || out_size != NTOK * DM || in_sizes[0] != NPROMPT * DM) { fprintf(stderr, "kernel_launch: bad shapes n_in %d ws %zu out %d\n", n_in, ws_size, out_size); grid = -1; return; }
        int dev = 0, cus = 0, per_cu = 0;
        hipGetDevice(&dev);
        hipDeviceGetAttribute(&cus, hipDeviceAttributeMultiprocessorCount, dev);
        if (hipFuncSetAttribute((const void*)mega_fwd, hipFuncAttributeMaxDynamicSharedMemorySize, LDS_BYTES) != hipSuccess) { fprintf(stderr, "kernel_launch: hipFuncSetAttribute failed\n"); grid = -1; return; }
        if (hipOccupancyMaxActiveBlocksPerMultiprocessor(&per_cu, (const void*)mega_fwd, NWAVES * 64, LDS_BYTES) != hipSuccess || per_cu < 1) { fprintf(stderr, "kernel_launch: occupancy query says %d\n", per_cu); }
        (void)hipGetLastError();
        if (cus != 256) { fprintf(stderr, "kernel_launch: built for 256 CUs, found %d\n", cus); grid = -1; return; }
        grid = cus;
    }
    if (grid < 0) return;
    Args a{};
    for (int i = 0; i < 17; ++i) a.in[i] = (const float*)d_in[i];
    a.out = (float*)d_out; a.ws = (unsigned char*)d_ws;
    const double two_pi = 6.283185307179586476925286766559;
    for (int i = 0; i < 64; ++i) a.invf_t[i] = pow(10000.0, -(double)i / 64.0) / two_pi;
    for (int i = 0; i < 32; ++i) a.invf_ax[i] = pow(10000.0, -(double)i / 32.0) / two_pi;
    void* kargs[] = {&a};
    hipError_t e = hipLaunchCooperativeKernel((const void*)mega_fwd, dim3(grid), dim3(NWAVES * 64), kargs, LDS_BYTES, stream);
    if (e != hipSuccess) fprintf(stderr, "kernel_launch: cooperative launch failed: %s (grid %d)\n", hipGetErrorString(e), grid);
}
```
